# Optimizing an MI355X kernel written in HIP

```python
import math
import jax, jax.numpy as jnp
from jax import lax
import numpy as np

D_MODEL = 1024
BATCH = 8
SEQ = 2048
DEPTH = 4
DEC_BATCH = 128
DEC_SEQ = 4
PAST_LEN = 16384
PAGE_SIZE = 128

N_EVEN = (DEPTH + 1) // 2
N_ODD = DEPTH // 2
EPS = 1e-6

POOL_WINDOWS = (2, 4, 8, 16)
N_POOL_GROUPS = len(POOL_WINDOWS)
D_POOL = D_MODEL // 2
POOL_GROUP = D_POOL // N_POOL_GROUPS
POOL_BUF = max(POOL_WINDOWS) - 1

N_MHEADS = 4
D_QK = D_MODEL // 8
D_HV = D_MODEL // 8
D_MQK = N_MHEADS * D_QK
D_MLSTM = N_MHEADS * D_HV
MLSTM_CHUNK = 128

EVEN_SPLITS = [int(s) for s in np.cumsum([D_POOL, D_MQK, D_MQK, D_MLSTM, D_MLSTM, N_MHEADS])]
D_IN_EVEN = D_POOL + 2 * D_MQK + 2 * D_MLSTM + 2 * N_MHEADS
D_MIX_EVEN = D_POOL + D_MLSTM

GMLP_CHUNK = 128
N_SGU_GROUPS = 4
D_SGU = D_MODEL
SGU_GROUP = D_SGU // N_SGU_GROUPS

D_FF = 2816
CONV_W = 3

kernel_name = "hybrid_pool_mlstm_sgu_convffn_step"


def rms_norm(x, g):
    xf = x.astype(jnp.float32)
    y = xf * lax.rsqrt(jnp.mean(xf * xf, axis=-1, keepdims=True) + EPS)
    return (y * g.astype(jnp.float32)).astype(x.dtype)


def layer_norm(x, g, b):
    xf = x.astype(jnp.float32)
    mu = jnp.mean(xf, axis=-1, keepdims=True)
    xc = xf - mu
    y = xc * lax.rsqrt(jnp.mean(xc * xc, axis=-1, keepdims=True) + EPS)
    return (y * g.astype(jnp.float32) + b.astype(jnp.float32)).astype(x.dtype)


def pool_mixer(p, buf, pos0, w_grp, scale):
    B, L, _ = p.shape
    ext = jnp.concatenate([buf.astype(p.dtype), p], axis=1)
    ef = ext.astype(jnp.float32)
    cs = jnp.concatenate([jnp.zeros((B, 1, D_POOL), jnp.float32), jnp.cumsum(ef, axis=1)], axis=1)
    hi = cs[:, POOL_BUF + 1:]
    pos = pos0 + jnp.arange(L)
    outs = []
    for g, w in enumerate(POOL_WINDOWS):
        sl = slice(g * POOL_GROUP, (g + 1) * POOL_GROUP)
        lo = cs[:, POOL_BUF + 1 - w:POOL_BUF + 1 - w + L, sl]
        cnt = jnp.minimum(w, pos + 1).astype(jnp.float32)[None, :, None]
        outs.append((hi[..., sl] - lo) / cnt - ef[:, POOL_BUF:, sl])
    d = jnp.stack(outs, axis=2)
    y = jnp.einsum('blgc,gcd->blgd', d, w_grp.astype(jnp.float32)).reshape(B, L, D_POOL)
    y = y * scale.astype(jnp.float32)
    return y.astype(p.dtype), ext[:, -POOL_BUF:]


def mlstm_chunk(carry, inp):
    C, n, m = carry
    q, k, v, ig, lf = inp
    L = q.shape[2]
    b = jnp.cumsum(lf, axis=-1)
    causal = jnp.tril(jnp.ones((L, L), dtype=bool))
    D = jnp.where(causal, b[..., :, None] - b[..., None, :] + ig[..., None, :], -jnp.inf)
    inter = b + m[..., None]
    m_t = jnp.maximum(inter, jnp.max(D, axis=-1))
    S = jnp.einsum('bhtk,bhsk->bhts', q, k) * jnp.exp(D - m_t[..., None])
    a = jnp.exp(inter - m_t)
    num = a[..., None] * jnp.einsum('bhtk,bhkv->bhtv', q, C) + jnp.einsum('bhts,bhsv->bhtv', S, v)
    den = a * jnp.einsum('bhtk,bhk->bht', q, n) + jnp.sum(S, axis=-1)
    h = num / jnp.maximum(jnp.abs(den), jnp.exp(-m_t))[..., None]
    m_new = m_t[..., -1]
    w_s = jnp.exp(b[..., -1:] - b + ig - m_new[..., None])
    a_L = jnp.exp(b[..., -1] + m - m_new)
    C_new = a_L[..., None, None] * C + jnp.einsum('bhs,bhsk,bhsv->bhkv', w_s, k, v)
    n_new = a_L[..., None] * n + jnp.einsum('bhs,bhsk->bhk', w_s, k)
    return (C_new, n_new, m_new), h


def mlstm(q, k, v, ig, lf, C0, n0, m0):
    B, H, L, _ = q.shape
    c = MLSTM_CHUNK if L % MLSTM_CHUNK == 0 else L
    nc = L // c

    def to_chunks(a):
        return jnp.moveaxis(a.reshape(B, H, nc, c, *a.shape[3:]), 2, 0)

    (C, n, m), h = lax.scan(mlstm_chunk, (C0, n0, m0),
                            (to_chunks(q), to_chunks(k), to_chunks(v), to_chunks(ig), to_chunks(lf)))
    h = jnp.moveaxis(h, 0, 2).reshape(B, H, L, D_HV)
    return h, C, n, m


def even_layer(x, pool_buf, C0, n0, m0, pos0, g_norm, w_in, b_gates, w_pool, pool_scale, g_head, w_out):
    B, L, _ = x.shape
    f32 = jnp.float32
    z = rms_norm(x, g_norm) @ w_in
    p, q, k, v, o, gates = jnp.split(z, EVEN_SPLITS[:5] + [EVEN_SPLITS[4] + 0], axis=-1)[:6] if False else jnp.split(z, EVEN_SPLITS[:5], axis=-1)
    gates = gates.astype(f32) + b_gates.astype(f32)
    ig = jnp.transpose(gates[..., :N_MHEADS], (0, 2, 1))
    lf = jnp.transpose(jax.nn.log_sigmoid(gates[..., N_MHEADS:]), (0, 2, 1))

    def heads(a, d):
        return jnp.transpose(a.reshape(B, L, N_MHEADS, d), (0, 2, 1, 3)).astype(f32)

    qh = heads(q, D_QK)
    kh = heads(k, D_QK) * (D_QK ** -0.5)
    vh = heads(v, D_HV)
    h, C, n, m = mlstm(qh, kh, vh, ig, lf, C0.astype(f32), n0.astype(f32), m0.astype(f32))
    h = rms_norm(jnp.transpose(h, (0, 2, 1, 3)), g_head.reshape(N_MHEADS, D_HV))
    y_b = (jax.nn.sigmoid(o.astype(f32)) * h.reshape(B, L, D_MLSTM)).astype(x.dtype)
    y_a, new_buf = pool_mixer(p, pool_buf, pos0, w_pool, pool_scale)
    y = jnp.concatenate([y_a, y_b], axis=-1) @ w_out
    return x + y, new_buf, C, n, m


def odd_layer(x, g_norm, w_in, ln_g, ln_b, w_s, b_s, w_out):
    B, L, _ = x.shape
    z = jax.nn.gelu(rms_norm(x, g_norm) @ w_in)
    u, v = jnp.split(z, 2, axis=-1)
    v = layer_norm(v, ln_g, ln_b)
    ws = w_s * jnp.tril(jnp.ones((GMLP_CHUNK, GMLP_CHUNK), w_s.dtype))
    vg = v.reshape(B, L, N_SGU_GROUPS, SGU_GROUP)
    if L % GMLP_CHUNK == 0:
        vc = vg.reshape(B, L // GMLP_CHUNK, GMLP_CHUNK, N_SGU_GROUPS, SGU_GROUP)
        s = jnp.einsum('grs,bcsgd->bcrgd', ws, vc) + b_s.T[None, None, :, :, None]
    else:
        s = jnp.einsum('grs,bsgd->brgd', ws[:, :L, :L], vg) + b_s[:, :L].T[None, :, :, None]
    s = s.reshape(B, L, D_SGU)
    y = (u * s) @ w_out
    return x + y, v


def conv_ffn(x, conv_buf, g_norm, w_gate, w_up, conv_w, conv_b, w_down):
    L = x.shape[1]
    h = rms_norm(x, g_norm)
    a = h @ w_gate
    u = h @ w_up
    ext = jnp.concatenate([conv_buf.astype(a.dtype), a], axis=1)
    ac = conv_b + ext[:, 0:L] * conv_w[0]
    for j in range(1, CONV_W):
        ac = ac + ext[:, j:j + L] * conv_w[j]
    y = (jax.nn.gelu(ac) * u) @ w_down
    return x + y, ext[:, -(CONV_W - 1):]


def trunk(x, pool_buf, m_c, m_n, m_m, conv_buf, pos0,
          g_mix, w_in_even, b_gates, w_pool, pool_scale, g_head, w_out_even,
          w_in_odd, ln_v_g, ln_v_b, w_spatial, b_spatial, w_out_odd,
          g_ffn, w_ffn_gate, w_ffn_up, conv_w, conv_b, w_ffn_down, g_final):
    pools, cs, ns, ms, convs, vs = [], [], [], [], [], []
    for l in range(DEPTH):
        if l % 2 == 0:
            e = l // 2
            x, pb, C, n, m = even_layer(x, pool_buf[e], m_c[e], m_n[e], m_m[e], pos0, g_mix[l],
                                        w_in_even[e], b_gates[e], w_pool[e], pool_scale[e], g_head[e], w_out_even[e])
            pools.append(pb); cs.append(C); ns.append(n); ms.append(m)
        else:
            o = l // 2
            x, v = odd_layer(x, g_mix[l], w_in_odd[o], ln_v_g[o], ln_v_b[o], w_spatial[o], b_spatial[o], w_out_odd[o])
            vs.append(v)
        x, cb = conv_ffn(x, conv_buf[l], g_ffn[l], w_ffn_gate[l], w_ffn_up[l], conv_w[l], conv_b[l], w_ffn_down[l])
        convs.append(cb)
    y = rms_norm(x, g_final)
    return (y, jnp.stack(pools), jnp.stack(cs), jnp.stack(ns), jnp.stack(ms), jnp.stack(convs), jnp.stack(vs))


def setup_inputs(seed: int = 0) -> dict:
    key = jax.random.key(seed)
    ks = iter(jax.random.split(key, 40))
    nrm = lambda shape, s=1.0: s * jax.random.normal(next(ks), shape, jnp.float32)
    gain = lambda shape: 1.0 + nrm(shape, 0.05)
    b_gates = jnp.concatenate([nrm((N_EVEN, N_MHEADS), 0.1),
                               3.0 + nrm((N_EVEN, N_MHEADS), 0.1)], axis=-1)
    return {
        "x_prompt": nrm((BATCH, SEQ, D_MODEL)),
        "x_sample": nrm((DEC_BATCH, DEC_SEQ, D_MODEL)),
        "state_pool": nrm((N_EVEN, DEC_BATCH, POOL_BUF, D_POOL)),
        "state_mlstm_c": nrm((N_EVEN, DEC_BATCH, N_MHEADS, D_QK, D_HV), 0.1),
        "state_mlstm_n": nrm((N_EVEN, DEC_BATCH, N_MHEADS, D_QK), 0.1),
        "state_mlstm_m": nrm((N_EVEN, DEC_BATCH, N_MHEADS)),
        "state_ffn_conv": nrm((DEPTH, DEC_BATCH, CONV_W - 1, D_FF)),
        "g_mix": gain((DEPTH, D_MODEL)),
        "w_in_even": nrm((N_EVEN, D_MODEL, D_IN_EVEN), D_MODEL ** -0.5),
        "b_gates": b_gates,
        "w_pool": nrm((N_EVEN, N_POOL_GROUPS, POOL_GROUP, POOL_GROUP), POOL_GROUP ** -0.5),
        "pool_scale": gain((N_EVEN, D_POOL)),
        "g_head": gain((N_EVEN, D_MLSTM)),
        "w_out_even": nrm((N_EVEN, D_MIX_EVEN, D_MODEL), D_MIX_EVEN ** -0.5),
        "w_in_odd": nrm((N_ODD, D_MODEL, 2 * D_SGU), D_MODEL ** -0.5),
        "ln_v_g": gain((N_ODD, D_SGU)),
        "ln_v_b": nrm((N_ODD, D_SGU), 0.02),
        "w_spatial": nrm((N_ODD, N_SGU_GROUPS, GMLP_CHUNK, GMLP_CHUNK), GMLP_CHUNK ** -0.5),
        "b_spatial": 1.0 + nrm((N_ODD, N_SGU_GROUPS, GMLP_CHUNK), 0.1),
        "w_out_odd": nrm((N_ODD, D_SGU, D_MODEL), D_SGU ** -0.5),
        "g_ffn": gain((DEPTH, D_MODEL)),
        "w_ffn_gate": nrm((DEPTH, D_MODEL, D_FF), D_MODEL ** -0.5),
        "w_ffn_up": nrm((DEPTH, D_MODEL, D_FF), D_MODEL ** -0.5),
        "conv_w": nrm((DEPTH, CONV_W, D_FF), CONV_W ** -0.5),
        "conv_b": nrm((DEPTH, D_FF), 0.02),
        "w_ffn_down": nrm((DEPTH, D_FF, D_MODEL), D_FF ** -0.5),
        "g_final": gain((D_MODEL,)),
    }


def reference(x_prompt, x_sample, state_pool, state_mlstm_c, state_mlstm_n, state_mlstm_m, state_ffn_conv,
              g_mix, w_in_even, b_gates, w_pool, pool_scale, g_head, w_out_even,
              w_in_odd, ln_v_g, ln_v_b, w_spatial, b_spatial, w_out_odd,
              g_ffn, w_ffn_gate, w_ffn_up, conv_w, conv_b, w_ffn_down, g_final):
    weights = (g_mix, w_in_even, b_gates, w_pool, pool_scale, g_head, w_out_even,
               w_in_odd, ln_v_g, ln_v_b, w_spatial, b_spatial, w_out_odd,
               g_ffn, w_ffn_gate, w_ffn_up, conv_w, conv_b, w_ffn_down, g_final)
    B = x_prompt.shape[0]
    f32 = jnp.float32
    y_p, pool_p, c_p, n_p, m_p, conv_p, _ = trunk(
        x_prompt,
        jnp.zeros((N_EVEN, B, POOL_BUF, D_POOL), x_prompt.dtype),
        jnp.zeros((N_EVEN, B, N_MHEADS, D_QK, D_HV), f32),
        jnp.zeros((N_EVEN, B, N_MHEADS, D_QK), f32),
        jnp.zeros((N_EVEN, B, N_MHEADS), f32),
        jnp.zeros((DEPTH, B, CONV_W - 1, D_FF), x_prompt.dtype),
        0, *weights)
    y_s, pool_s, c_s, n_s, m_s, conv_s, v_s = trunk(
        x_sample, state_pool, state_mlstm_c, state_mlstm_n, state_mlstm_m, state_ffn_conv,
        PAST_LEN, *weights)
    return (y_p, y_s, pool_p, pool_s, c_p, c_s, n_p, n_s, m_p, m_s, conv_p, conv_s, v_s)
```

```cpp
#include <hip/hip_runtime.h>
#include <hip/hip_cooperative_groups.h>
#include <cstdio>
#include <cstring>
namespace cg = cooperative_groups;

#define LAS __attribute__((address_space(3)))
typedef unsigned short bf16_t;
typedef short bf16x8 __attribute__((ext_vector_type(8)));
typedef float f32x4 __attribute__((ext_vector_type(4)));
typedef unsigned u32x4 __attribute__((ext_vector_type(4)));
typedef unsigned u32x2 __attribute__((ext_vector_type(2)));

#ifndef USE_CG_SYNC
#define USE_CG_SYNC 0
#endif
#ifndef ONE_LAUNCH
#define ONE_LAUNCH 1

#endif

constexpr int MTOK = 16896, MP = 16384, DM = 1024, NZ = 2560, FF = 2816, AUW = 5632;
constexpr float EPS = 1e-6f;
constexpr int NPHASE = 30;
constexpr int LDS_BYTES = 147456;

constexpr size_t O_POOLP = 17301504, O_POOLS = 17424384, O_CP = 19390464, O_CS = 20439040, O_NP = 37216256, O_NS = 37224448,
                 O_MP = 37355520, O_MS = 37355584, O_CONVP = 37356608, O_CONVS = 37536832, O_V = 40420416;

constexpr size_t WS_EIN = 0;
constexpr size_t WS_EOUT = WS_EIN + 2ull * 2560 * 1024 * 2;
constexpr size_t WS_OIN = WS_EOUT + 2ull * 1024 * 1024 * 2;
constexpr size_t WS_OOUT = WS_OIN + 2ull * 2048 * 1024 * 2;
constexpr size_t WS_F1 = WS_OOUT + 2ull * 1024 * 1024 * 2;
constexpr size_t WS_F2 = WS_F1 + 4ull * 5632 * 1024 * 2;
constexpr size_t WS_WG = WS_F2 + 4ull * 1024 * 2816 * 2;
constexpr size_t WS_WPOOL = WS_WG + 2ull * 8 * 1024 * 4;
constexpr size_t WS_WSP = WS_WPOOL + 2ull * 4 * 128 * 128 * 2;
constexpr size_t WS_XB = WS_WSP + 2ull * 4 * 128 * 128 * 2;
constexpr size_t WS_SS = WS_XB + (size_t)MTOK * 1024 * 2;
constexpr size_t WS_BIG = WS_SS + 16ull * MTOK * 4;
constexpr size_t WS_BAR = WS_BIG + (size_t)MTOK * AUW * 2;
constexpr size_t WS_WGB = WS_BAR + 16384;
constexpr size_t WS_END = WS_WGB + 2ull * 16 * 1024 * 2;
constexpr size_t B_ZB = 0;
constexpr size_t B_GATES = B_ZB + (size_t)MTOK * NZ * 2;
constexpr size_t B_BT = B_GATES + (size_t)MTOK * 8 * 4;
constexpr size_t B_SCAL = B_BT + (size_t)MP * 4 * 4;
constexpr size_t B_DC = B_SCAL + 512 * 4 * 4;
constexpr size_t B_DN = B_DC + 512ull * 16384 * 4;
constexpr size_t B_CPREV = B_DN + 512ull * 128 * 4;
constexpr size_t B_NPREV = B_CPREV + 512ull * 16384 * 2;
constexpr size_t B_YMIX = B_NPREV + 512ull * 128 * 4;
constexpr size_t B_EVEN_END = B_YMIX + (size_t)MTOK * 1024 * 2;
static_assert(B_EVEN_END <= (size_t)MTOK * AUW * 2, "even scratch too big");
constexpr size_t B_G = 0;
constexpr size_t B_AUS = B_G + (size_t)MTOK * FF * 2;
constexpr size_t B_HF = B_AUS + 512ull * AUW * 2;
constexpr size_t B_HU = B_HF + 256ull * 2 * FF * 4;
constexpr size_t B_HL = B_HU + 256ull * 2 * FF * 4;
constexpr size_t B_U = 0;
constexpr size_t B_VPRE = B_U + (size_t)MTOK * 1024 * 2;
constexpr size_t B_LNS = B_VPRE + (size_t)MTOK * 1024 * 2;
constexpr size_t B_US = B_LNS + 2ull * 16 * MTOK * 4;

struct TJob { const float* W; bf16_t* WT; const float* gk; int K, ldw, ncols, ldt, n_lo, n_hi; float nscale; int item0; int rmode, roff; };
constexpr int NJOBS = 20;
struct Params {
    const float* in[27];
    float* out;
    unsigned char* ws;
    TJob jobs[NJOBS];
    int nitems; int pad;
};

typedef const __attribute__((address_space(4))) Params CParams;
typedef const __attribute__((address_space(4))) TJob CTJob;

__device__ __forceinline__ unsigned cvt_pk_bf16(float lo, float hi) { unsigned r; asm volatile("v_cvt_pk_bf16_f32 %0, %1, %2" : "=v"(r) : "v"(lo), "v"(hi)); return r; }
__device__ __forceinline__ bf16_t f2bf(float f) { return (bf16_t)(cvt_pk_bf16(f, 0.f) & 0xffffu); }
__device__ __forceinline__ float bf2f(bf16_t b) { return __uint_as_float(((unsigned)b) << 16); }
__device__ __forceinline__ float bflo(unsigned u) { return __uint_as_float(u << 16); }
__device__ __forceinline__ float bfhi(unsigned u) { return __uint_as_float(u & 0xffff0000u); }
__device__ __forceinline__ float wave_sum(float v) {
#pragma unroll
    for (int o = 1; o < 64; o <<= 1) v += __shfl_xor(v, o);
    return v;
}
__device__ __forceinline__ float wave_max(float v) {
#pragma unroll
    for (int o = 1; o < 64; o <<= 1) v = fmaxf(v, __shfl_xor(v, o));
    return v;
}
__device__ __forceinline__ float gelu_t(float x) {
    const float x2 = x * x;
    const float t = x * __builtin_fmaf(x2, -0.10294324f, -2.3022082f);
    return x * __builtin_amdgcn_rcpf(1.f + __builtin_amdgcn_exp2f(t));
}
typedef float f32x2 __attribute__((ext_vector_type(2)));
__device__ __forceinline__ f32x2 gelu_t2(f32x2 v) {
    const f32x2 x2 = v * v;
    const f32x2 t = v * (x2 * (-0.10294324f) + (-2.3022082f));
    f32x2 e; e.x = __builtin_amdgcn_exp2f(t.x); e.y = __builtin_amdgcn_exp2f(t.y);
    const f32x2 d = e + 1.0f;
    f32x2 r; r.x = __builtin_amdgcn_rcpf(d.x); r.y = __builtin_amdgcn_rcpf(d.y);
    return v * r;
}
__device__ __forceinline__ float sigmoidf_(float x) { return __builtin_amdgcn_rcpf(1.f + __expf(-x)); }
__device__ __forceinline__ void unpack8(const u32x4 v, float (&f)[8]) {
    f[0] = bflo(v.x); f[1] = bfhi(v.x); f[2] = bflo(v.y); f[3] = bfhi(v.y); f[4] = bflo(v.z); f[5] = bfhi(v.z); f[6] = bflo(v.w); f[7] = bfhi(v.w);
}
__device__ __forceinline__ u32x4 pack8(const float (&f)[8]) {
    u32x4 o; o.x = cvt_pk_bf16(f[0], f[1]); o.y = cvt_pk_bf16(f[2], f[3]); o.z = cvt_pk_bf16(f[4], f[5]); o.w = cvt_pk_bf16(f[6], f[7]); return o;
}
__device__ __forceinline__ int get_tid() { int t = threadIdx.x; asm volatile("" : "+v"(t)); return t; }
__device__ __forceinline__ int get_bid() { int t = blockIdx.x; asm volatile("" : "+s"(t)); return t; }
__device__ __forceinline__ int get_gdim() { int t = gridDim.x; asm volatile("" : "+s"(t)); return t; }
#define LDS_WAIT() asm volatile("s_waitcnt lgkmcnt(0)" ::: "memory")

namespace pg8 {
constexpr int BM = 256, BK = 64, HALF = 128, HTB = HALF * BK * 2, STAGE_BYTES = 8 * HTB, NXCD = 8, WGM = 8;
__device__ __forceinline__ int lds_byte(int r, int c) { const int st = (r >> 4) * 2 + (c >> 5), rr = r & 15, cc = c & 31, ob = rr * 64 + cc * 2; return st * 1024 + (ob ^ (((ob >> 9) & 1) << 5)); }
__device__ __forceinline__ void stage_rc(int b, int& R, int& C) { const int st = b / 1024, sb = b % 1024, swz = sb ^ (((sb >> 9) & 1) << 5); R = (st >> 1) * 16 + swz / 64; C = (st & 1) * 32 + (swz % 64) / 2; }
__device__ __forceinline__ int perm32(int rho) { const int n = rho >> 4, i = rho & 15; return 8 * (i >> 2) + 4 * n + (i & 3); }
struct Unit { int pm, pn; };
struct Gemm { const bf16_t* A; const bf16_t* Bt; int M, N, K, lda, ldb; };
struct StaticOrder {
    int nM, nN, nwg, G, c;
    __device__ void init(int M, int N, int G_, int c_) { nM = M / BM; nN = N / BM; nwg = nM * nN; G = G_; c = c_; }
    __device__ bool next(int i, Unit& u) const {
        const long L = (long)i * G + c; if (L >= nwg) return false;
        int wgid = (int)L; { const int q = nwg / NXCD, r = nwg % NXCD, xcd = wgid % NXCD, off = wgid / NXCD; wgid = (xcd < r ? xcd * (q + 1) : r * (q + 1) + (xcd - r) * q) + off; }
        const int nig = WGM * nN, gid = wgid / nig, fm = gid * WGM, gsz = (nM - fm) < WGM ? (nM - fm) : WGM;
        u.pm = fm + ((wgid % nig) % gsz); u.pn = (wgid % nig) / gsz; return true;
    }
    __device__ __forceinline__ void a_ready(const Unit&, int) const {}
};
__device__ __forceinline__ void precompute_rstd(const StaticOrder& S, const float* ss, LAS float* rs) {
    const int tid = get_tid(), half = tid >> 8, row = tid & 255;
    float sum[3]; bool ok[3];
#pragma unroll
    for (int k = 0; k < 3; ++k) { Unit u; ok[k] = S.next(half + 2 * k, u); sum[k] = 0.f;
        if (ok[k]) { const int r = u.pm * BM + row;
#pragma unroll
            for (int j = 0; j < 16; ++j) sum[k] += ss[(size_t)j * MTOK + r]; } }
#pragma unroll
    for (int k = 0; k < 3; ++k) if (ok[k]) rs[(half + 2 * k) * 256 + row] = rsqrtf(sum[k] * (1.f / 1024.f) + EPS);
    __syncthreads();
}

template <class Epi, class Sched>
__device__ __forceinline__ void gemm_phase(LAS unsigned char* lds, const Gemm g, const Sched& S, const Epi& E) {
    const int tid = get_tid(), wid = __builtin_amdgcn_readfirstlane(tid >> 6), lane = tid & 63, wr = wid >> 2, wc = wid & 3, fr = lane & 15, fq = lane >> 4;
    const int K = g.K, nt = K / BK;
    unsigned voffA, voffB;
    { int R, C; stage_rc(tid * 16, R, C);
      const int Rb = (R & ~31) + perm32(R & 31);
      voffA = (unsigned)(R * g.lda + C) * 2u; voffB = (unsigned)(Rb * g.ldb + C) * 2u; }
    const size_t dstepA = (size_t)64 * g.lda * 2, dstepB = (size_t)64 * g.ldb * 2;
    const size_t kstep = (size_t)(BK * 2);
    const size_t hstepA = (size_t)HALF * g.lda * 2, hstepB = (size_t)HALF * g.ldb * 2;
    const size_t tstepA = 2 * hstepA, tstepB = 2 * hstepB;
    const unsigned ldsw = (unsigned)wid * 1024u;
    const int aoff = lds_byte(wr * 64 + fr, fq * 8), boff = lds_byte(wc * 32 + fr, fq * 8);
#define PG8_SA(b, h) (((b) * 2 + (h)) * HTB)
#define PG8_SB(b, h) ((4 + (b) * 2 + (h)) * HTB)
#define PG8_STAGE(bufoff, gbase, voff) do { _Pragma("unroll") for (int _i = 0; _i < 2; ++_i) \
        __builtin_amdgcn_global_load_lds((const unsigned*)((const char*)(gbase) + (size_t)_i * d##voff + (voff)), (LAS unsigned*)(lds + (bufoff) + ldsw + _i * 8192), 16, 0, 0); } while (0)
#define dvoffA dstepA
#define dvoffB dstepB
#define PG8_LDA(dst, b, h) do { _Pragma("unroll") for (int m = 0; m < 4; ++m) _Pragma("unroll") for (int k = 0; k < 2; ++k) dst[m][k] = *(const LAS bf16x8*)(lds + PG8_SA(b, h) + aoff + m * 2048 + k * 1024); } while (0)
#define PG8_LDB(dst, b, h) do { _Pragma("unroll") for (int n = 0; n < 2; ++n) _Pragma("unroll") for (int k = 0; k < 2; ++k) dst[n][k] = *(const LAS bf16x8*)(lds + PG8_SB(b, h) + boff + n * 2048 + k * 1024); } while (0)
#define PG8_MMA(ai, bj, At, Bt) do { __builtin_amdgcn_s_setprio(1); _Pragma("unroll") for (int m = 0; m < 4; ++m) _Pragma("unroll") for (int n = 0; n < 2; ++n) _Pragma("unroll") for (int k = 0; k < 2; ++k) \
        acc[ai][bj][m][n] = __builtin_amdgcn_mfma_f32_16x16x32_bf16(Bt[n][k], At[m][k], acc[ai][bj][m][n], 0, 0, 0); __builtin_amdgcn_s_setprio(0); } while (0)
#define PG8_WAIT_V(n) asm volatile("s_waitcnt vmcnt(" #n ")" ::: "memory")
#define PG8_WAIT_L(n) asm volatile("s_waitcnt lgkmcnt(" #n ")" ::: "memory")
#define PG8_BAR __builtin_amdgcn_s_barrier()
#define PG8_SCHED __builtin_amdgcn_sched_barrier(0)
    Unit cur, nxt; int ui = 0;
    if (!S.next(0, cur)) return;
    f32x4 acc[2][2][4][2];
#pragma unroll
    for (int a = 0; a < 2; ++a)
#pragma unroll
        for (int b = 0; b < 2; ++b)
#pragma unroll
            for (int m = 0; m < 4; ++m)
#pragma unroll
                for (int n = 0; n < 2; ++n) acc[a][b][m][n] = (f32x4){0.f, 0.f, 0.f, 0.f};
    bf16x8 At[4][2], B0[2][2], B1[2][2];
    const char* cA = (const char*)g.A + (size_t)cur.pm * tstepA; const char* cB = (const char*)g.Bt + (size_t)cur.pn * tstepB;
    S.a_ready(cur, 0);
    PG8_STAGE(PG8_SB(0, 0), cB, voffB); PG8_STAGE(PG8_SA(0, 0), cA, voffA); PG8_STAGE(PG8_SB(0, 1), cB + hstepB, voffB); PG8_STAGE(PG8_SA(0, 1), cA + hstepA, voffA);
    if (wr == 1) PG8_BAR;
    PG8_WAIT_V(4); PG8_BAR;
    PG8_STAGE(PG8_SB(1, 0), cB + kstep, voffB); PG8_STAGE(PG8_SA(1, 0), cA + kstep, voffA); PG8_STAGE(PG8_SB(1, 1), cB + hstepB + kstep, voffB);
    PG8_WAIT_V(6); PG8_BAR;
    for (;;) {
        const bool has_next = S.next(ui + 1, nxt);
        const char* nA = has_next ? (const char*)g.A + (size_t)nxt.pm * tstepA : cA; const char* nB = has_next ? (const char*)g.Bt + (size_t)nxt.pn * tstepB : cB;
        for (int t = 0; t < nt; t += 2) {
            const bool last = (t == nt - 2);
            const char* a1 = cA + (size_t)(t + 1) * kstep;
            const char* a2 = last ? nA : cA + (size_t)(t + 2) * kstep; const char* b2 = last ? nB : cB + (size_t)(t + 2) * kstep;
            const char* a3 = a2 + kstep; const char* b3 = b2 + kstep;
            if (last && has_next) S.a_ready(nxt, ui + 1);
            PG8_LDB(B0, 0, 0); PG8_SCHED; PG8_LDA(At, 0, 0); PG8_STAGE(PG8_SA(1, 1), a1 + hstepA, voffA);
            PG8_WAIT_L(8); PG8_BAR; PG8_WAIT_L(0); PG8_MMA(0, 0, At, B0); PG8_BAR; PG8_SCHED;
            PG8_LDB(B1, 0, 1); PG8_STAGE(PG8_SB(0, 0), b2, voffB);
            PG8_BAR; PG8_WAIT_L(0); PG8_MMA(0, 1, At, B1); PG8_BAR;
            PG8_LDA(At, 0, 1); PG8_STAGE(PG8_SA(0, 0), a2, voffA);
            PG8_BAR; PG8_WAIT_L(0); PG8_MMA(1, 0, At, B0); PG8_BAR; PG8_SCHED;
            PG8_STAGE(PG8_SB(0, 1), b2 + hstepB, voffB);
            PG8_WAIT_V(6); PG8_BAR; PG8_MMA(1, 1, At, B1); PG8_BAR;
            PG8_LDB(B0, 1, 0); PG8_SCHED; PG8_LDA(At, 1, 0); PG8_STAGE(PG8_SA(0, 1), a2 + hstepA, voffA);
            PG8_WAIT_L(8); PG8_BAR; PG8_WAIT_L(0); PG8_MMA(0, 0, At, B0); PG8_BAR; PG8_SCHED;
            PG8_LDB(B1, 1, 1); PG8_STAGE(PG8_SB(1, 0), b3, voffB);
            PG8_BAR; PG8_WAIT_L(0); PG8_MMA(0, 1, At, B1); PG8_BAR;
            PG8_LDA(At, 1, 1); PG8_STAGE(PG8_SA(1, 0), a3, voffA);
            PG8_BAR; PG8_WAIT_L(0); PG8_MMA(1, 0, At, B0); PG8_BAR; PG8_SCHED;
            PG8_STAGE(PG8_SB(1, 1), b3 + hstepB, voffB);
            PG8_WAIT_V(6); PG8_BAR; PG8_MMA(1, 1, At, B1); PG8_BAR;
        }
        E(acc, cur, ui, wr, wc, fr, fq);
        if (!has_next) break;
#pragma unroll
        for (int a = 0; a < 2; ++a)
#pragma unroll
            for (int b = 0; b < 2; ++b)
#pragma unroll
                for (int m = 0; m < 4; ++m)
#pragma unroll
                    for (int n = 0; n < 2; ++n) acc[a][b][m][n] = (f32x4){0.f, 0.f, 0.f, 0.f};
        cur = nxt; cA = nA; cB = nB; ++ui;
    }
    PG8_WAIT_V(0);
    if (wr == 0) PG8_BAR;
    PG8_BAR;
#undef PG8_SA
#undef PG8_SB
#undef PG8_STAGE
#undef dvoffA
#undef dvoffB
#undef PG8_LDA
#undef PG8_LDB
#undef PG8_MMA
#undef PG8_WAIT_V
#undef PG8_WAIT_L
#undef PG8_BAR
#undef PG8_SCHED
}

struct EpiScaleBf16 {
    bf16_t* O; int ldc; LAS const float* rs;
    __device__ __forceinline__ void operator()(const f32x4 (&acc)[2][2][4][2], const Unit& u, int ui, int wr, int wc, int fr, int fq) const {
        LAS const float* r = rs + ui * 256;
#pragma unroll
        for (int ai = 0; ai < 2; ++ai)
#pragma unroll
            for (int m = 0; m < 4; ++m) {
                const int rl = ai * HALF + wr * 64 + m * 16 + fr; const float s = r[rl];
                bf16_t* rowp = O + (size_t)(u.pm * BM + rl) * ldc + u.pn * BM + wc * 32 + 8 * fq;
#pragma unroll
                for (int bj = 0; bj < 2; ++bj) { const f32x4 v0 = acc[ai][bj][m][0] * s, v1 = acc[ai][bj][m][1] * s;
                    u32x4 o; o.x = cvt_pk_bf16(v0[0], v0[1]); o.y = cvt_pk_bf16(v0[2], v0[3]); o.z = cvt_pk_bf16(v1[0], v1[1]); o.w = cvt_pk_bf16(v1[2], v1[3]);
                    *(u32x4*)(rowp + bj * HALF) = o; }
            }
    }
};
struct EpiOddIn {
    bf16_t* U; bf16_t* V; float* lns; LAS const float* rs;
    __device__ __forceinline__ void operator()(const f32x4 (&acc)[2][2][4][2], const Unit& u, int ui, int wr, int wc, int fr, int fq) const {
        LAS const float* r = rs + ui * 256;
        const bool isv = u.pn >= 4; bf16_t* O = isv ? V : U; const int pnl = isv ? u.pn - 4 : u.pn;
#pragma unroll
        for (int ai = 0; ai < 2; ++ai)
#pragma unroll
            for (int m = 0; m < 4; ++m) {
                const int rl = ai * HALF + wr * 64 + m * 16 + fr; const float s = r[rl]; const int row = u.pm * BM + rl;
                bf16_t* rowp = O + (size_t)row * 1024 + pnl * BM + wc * 32 + 8 * fq;
                float sm = 0.f, sq = 0.f;
#pragma unroll
                for (int bj = 0; bj < 2; ++bj) { unsigned pk[4];
#pragma unroll
                    for (int n = 0; n < 2; ++n) { f32x4 v = acc[ai][bj][m][n] * s;
                        { const f32x2 g0 = gelu_t2((f32x2){v[0], v[1]}), g1 = gelu_t2((f32x2){v[2], v[3]}); v[0] = g0.x; v[1] = g0.y; v[2] = g1.x; v[3] = g1.y; }
#pragma unroll
                        for (int j = 0; j < 4; ++j) { sm += v[j]; sq += v[j] * v[j]; }
                        pk[2 * n] = cvt_pk_bf16(v[0], v[1]); pk[2 * n + 1] = cvt_pk_bf16(v[2], v[3]); }
                    *(u32x4*)(rowp + bj * HALF) = (u32x4){pk[0], pk[1], pk[2], pk[3]}; }
                if (isv) {
                    sm += __shfl_xor(sm, 16); sm += __shfl_xor(sm, 32); sq += __shfl_xor(sq, 16); sq += __shfl_xor(sq, 32);
                    if (fq == 0) { const int slot = pnl * 4 + wc; lns[(size_t)slot * MTOK + row] = sm; lns[(size_t)(16 + slot) * MTOK + row] = sq; }
                }
            }
    }
};
__device__ __forceinline__ float dpp_ror1(float x) { return __int_as_float(__builtin_amdgcn_update_dpp(0, __float_as_int(x), 0x121, 0xf, 0xf, false)); }
__device__ __forceinline__ float dpp_ror2(float x) { return __int_as_float(__builtin_amdgcn_update_dpp(0, __float_as_int(x), 0x122, 0xf, 0xf, false)); }
__device__ __forceinline__ float dpp_shr1(float oldv, float x) { return __int_as_float(__builtin_amdgcn_update_dpp(__float_as_int(oldv), __float_as_int(x), 0x111, 0xf, 0xf, false)); }
__device__ __forceinline__ float dpp_shr2(float oldv, float x) { return __int_as_float(__builtin_amdgcn_update_dpp(__float_as_int(oldv), __float_as_int(x), 0x112, 0xf, 0xf, false)); }
struct EpiFfn {
    bf16_t* Gb; bf16_t* AUS; float* HF; float* HU; float* HL; LAS const float* rs; const float* cw; const float* cb;
    __device__ __forceinline__ void operator()(const f32x4 (&acc)[2][2][4][2], const Unit& u, int ui, int wr, int wc, int fr, int fq) const {
        LAS const float* r = rs + ui * 256;
        const int c0 = u.pn * 128 + wc * 32 + 8 * fq;
        if (u.pm >= 64) {
#pragma unroll
            for (int ai = 0; ai < 2; ++ai)
#pragma unroll
                for (int m = 0; m < 4; ++m) { const int rl = ai * HALF + wr * 64 + m * 16 + fr; const float sc = r[rl]; bf16_t* rowp = AUS + (size_t)((u.pm - 64) * BM + rl) * AUW + c0;
#pragma unroll
                    for (int bj = 0; bj < 2; ++bj) { const f32x4 v0 = acc[ai][bj][m][0] * sc, v1 = acc[ai][bj][m][1] * sc;
                        u32x4 o; o.x = cvt_pk_bf16(v0[0], v0[1]); o.y = cvt_pk_bf16(v0[2], v0[3]); o.z = cvt_pk_bf16(v1[0], v1[1]); o.w = cvt_pk_bf16(v1[2], v1[3]); *(u32x4*)(rowp + bj * FF) = o; } }
            return;
        }
        f32x4 w0[2], w1[2], w2[2], cbv[2];
#pragma unroll
        for (int n = 0; n < 2; ++n) { w0[n] = *(const f32x4*)(cw + c0 + 4 * n); w1[n] = *(const f32x4*)(cw + FF + c0 + 4 * n); w2[n] = *(const f32x4*)(cw + 2 * FF + c0 + 4 * n); cbv[n] = *(const f32x4*)(cb + c0 + 4 * n); }
#pragma unroll
        for (int ai = 0; ai < 2; ++ai) {
            const int rb = u.pm * 4 + ai * 2 + wr;
            f32x4 ap[2] = {(f32x4){0.f, 0.f, 0.f, 0.f}, (f32x4){0.f, 0.f, 0.f, 0.f}};
#pragma unroll
            for (int m = 0; m < 4; ++m) {
                const int rl = ai * HALF + wr * 64 + m * 16 + fr; const float sc = r[rl]; const size_t row = (size_t)u.pm * BM + rl;
                f32x4 a[2], uu[2];
#pragma unroll
                for (int n = 0; n < 2; ++n) { a[n] = acc[ai][0][m][n] * sc; uu[n] = acc[ai][1][m][n] * sc; }
                if (m == 0 && fr < 2) {
#pragma unroll
                    for (int n = 0; n < 2; ++n) { *(f32x4*)(HF + ((size_t)rb * 2 + fr) * FF + c0 + 4 * n) = a[n]; *(f32x4*)(HU + ((size_t)rb * 2 + fr) * FF + c0 + 4 * n) = uu[n]; } }
                if (m == 3 && fr >= 14) {
#pragma unroll
                    for (int n = 0; n < 2; ++n) *(f32x4*)(HL + ((size_t)rb * 2 + (fr - 14)) * FF + c0 + 4 * n) = a[n]; }
                unsigned gpk[4];
#pragma unroll
                for (int n = 0; n < 2; ++n) { f32x4 g;
#pragma unroll
                    for (int jp = 0; jp < 2; ++jp) {
                        const f32x2 cur = (f32x2){a[n][2 * jp], a[n][2 * jp + 1]}, pv = (f32x2){ap[n][2 * jp], ap[n][2 * jp + 1]};
                        f32x2 p1, p2; p1.x = dpp_shr1(dpp_ror1(pv.x), cur.x); p1.y = dpp_shr1(dpp_ror1(pv.y), cur.y); p2.x = dpp_shr2(dpp_ror2(pv.x), cur.x); p2.y = dpp_shr2(dpp_ror2(pv.y), cur.y);
                        const f32x2 cb2 = (f32x2){cbv[n][2 * jp], cbv[n][2 * jp + 1]}, w02 = (f32x2){w0[n][2 * jp], w0[n][2 * jp + 1]}, w12 = (f32x2){w1[n][2 * jp], w1[n][2 * jp + 1]}, w22 = (f32x2){w2[n][2 * jp], w2[n][2 * jp + 1]};
                        const f32x2 ac = cb2 + w02 * p2 + w12 * p1 + w22 * cur;
                        const f32x2 gg = gelu_t2(ac) * (f32x2){uu[n][2 * jp], uu[n][2 * jp + 1]};
                        g[2 * jp] = gg.x; g[2 * jp + 1] = gg.y; }
                    gpk[2 * n] = cvt_pk_bf16(g[0], g[1]); gpk[2 * n + 1] = cvt_pk_bf16(g[2], g[3]); }
                if (!(m == 0 && fr < 2)) *(u32x4*)(Gb + row * FF + c0) = (u32x4){gpk[0], gpk[1], gpk[2], gpk[3]};
                ap[0] = a[0]; ap[1] = a[1];
            }
        }
    }
};
struct EpiResid {
    bf16_t* XB; float* ss;
    __device__ __forceinline__ void operator()(const f32x4 (&acc)[2][2][4][2], const Unit& u, int ui, int wr, int wc, int fr, int fq) const {
        const size_t base = (size_t)(u.pm * BM + wr * 64 + fr) * 1024 + u.pn * BM + wc * 32 + 8 * fq;
        u32x4 xv[2][2];
#pragma unroll
        for (int bj = 0; bj < 2; ++bj) xv[0][bj] = *(const u32x4*)(XB + base + bj * HALF);
#pragma unroll
        for (int g = 0; g < 8; ++g) {
            const int ai = g >> 2, m = g & 3; const size_t off = base + (size_t)(ai * HALF + m * 16) * 1024;
            if (g < 7) { const int ai2 = (g + 1) >> 2, m2 = (g + 1) & 3; const size_t off2 = base + (size_t)(ai2 * HALF + m2 * 16) * 1024;
#pragma unroll
                for (int bj = 0; bj < 2; ++bj) xv[(g + 1) & 1][bj] = *(const u32x4*)(XB + off2 + bj * HALF); }
            float sq = 0.f;
#pragma unroll
            for (int bj = 0; bj < 2; ++bj) { const u32x4 xr = xv[g & 1][bj]; const f32x4 a0 = acc[ai][bj][m][0], a1 = acc[ai][bj][m][1];
                const float v0 = bflo(xr.x) + a0[0], v1 = bfhi(xr.x) + a0[1], v2 = bflo(xr.y) + a0[2], v3 = bfhi(xr.y) + a0[3];
                const float v4 = bflo(xr.z) + a1[0], v5 = bfhi(xr.z) + a1[1], v6 = bflo(xr.w) + a1[2], v7 = bfhi(xr.w) + a1[3];
                sq += v0 * v0 + v1 * v1 + v2 * v2 + v3 * v3 + v4 * v4 + v5 * v5 + v6 * v6 + v7 * v7;
                u32x4 o; o.x = cvt_pk_bf16(v0, v1); o.y = cvt_pk_bf16(v2, v3); o.z = cvt_pk_bf16(v4, v5); o.w = cvt_pk_bf16(v6, v7); *(u32x4*)(XB + off + bj * HALF) = o; }
            sq += __shfl_xor(sq, 16); sq += __shfl_xor(sq, 32);
            if (fq == 0) ss[(size_t)(u.pn * 4 + wc) * MTOK + u.pm * BM + ai * HALF + wr * 64 + m * 16 + fr] = sq;
        }
    }
};
}

constexpr int LDP = 136;
constexpr int TILE_B = 128 * LDP * 2;
__device__ __forceinline__ void stage_rows(LAS bf16_t* dst, const bf16_t* src, size_t ld, int tid) {
#pragma unroll
    for (int i = 0; i < 4; ++i) { const int idx = tid + 512 * i, r = idx >> 4, ch = idx & 15;
        const u32x4 v = *(const u32x4*)(src + (size_t)r * ld + ch * 8); *(LAS u32x4*)(dst + r * LDP + ch * 8) = v; }
}
template <bool SCALE>
__device__ __forceinline__ void stage_T(LAS bf16_t* dst, const bf16_t* src, size_t ld, LAS const float* wtok, int wid, int lane) {
    const int t0 = 2 * lane;
    float w0 = 1.f, w1 = 1.f; if (SCALE) { w0 = wtok[t0]; w1 = wtok[t0 + 1]; }
#pragma unroll
    for (int it = 0; it < 2; ++it) {
        const int fg = wid + 8 * it;
        const u32x4 va = *(const u32x4*)(src + (size_t)t0 * ld + fg * 8), vb = *(const u32x4*)(src + (size_t)(t0 + 1) * ld + fg * 8);
#pragma unroll
        for (int j = 0; j < 4; ++j) {
            unsigned lo, hi;
            if (SCALE) { lo = cvt_pk_bf16(bflo(va[j]) * w0, bflo(vb[j]) * w1); hi = cvt_pk_bf16(bfhi(va[j]) * w0, bfhi(vb[j]) * w1); }
            else { lo = (va[j] & 0xffffu) | (vb[j] << 16); hi = (va[j] >> 16) | (vb[j] & 0xffff0000u); }
            *(LAS unsigned*)(dst + (8 * fg + 2 * j) * LDP + t0) = lo;
            *(LAS unsigned*)(dst + (8 * fg + 2 * j + 1) * LDP + t0) = hi;
        }
    }
}
__device__ __forceinline__ void lds_gemm128(LAS const bf16_t* A, LAS const bf16_t* B, f32x4 (&acc)[2][4], int wr4, int wc2, int lane) {
    const int fr = lane & 15, fq = lane >> 4;
#pragma unroll
    for (int kk = 0; kk < 4; ++kk) {
        bf16x8 a[2], b[4];
#pragma unroll
        for (int mi = 0; mi < 2; ++mi) a[mi] = *(LAS const bf16x8*)(A + (32 * wr4 + 16 * mi + fr) * LDP + 32 * kk + 8 * fq);
#pragma unroll
        for (int ni = 0; ni < 4; ++ni) b[ni] = *(LAS const bf16x8*)(B + (64 * wc2 + 16 * ni + fr) * LDP + 32 * kk + 8 * fq);
#pragma unroll
        for (int mi = 0; mi < 2; ++mi)
#pragma unroll
            for (int ni = 0; ni < 4; ++ni) acc[mi][ni] = __builtin_amdgcn_mfma_f32_16x16x32_bf16(a[mi], b[ni], acc[mi][ni], 0, 0, 0);
    }
}
__device__ __forceinline__ void lds_put_pair(LAS bf16_t* T, int row, int col, int fr, float v) {
    const float other = __shfl_xor(v, 1);
    if (!(fr & 1)) *(LAS unsigned*)(T + row * LDP + col) = cvt_pk_bf16(v, other);
}
__device__ __forceinline__ void zero_acc(f32x4 (&acc)[2][4]) {
#pragma unroll
    for (int mi = 0; mi < 2; ++mi)
#pragma unroll
        for (int ni = 0; ni < 4; ++ni) acc[mi][ni] = (f32x4){0.f, 0.f, 0.f, 0.f};
}

__device__ __forceinline__ void transpose_item(CTJob& j, int item, LAS float* scr, int lane) {
    const int nblk = j.ncols / 32, kb = item / nblk, nb = item % nblk, k0 = 64 * kb, n0 = 32 * nb;
    float wv[32];
    const float* wp = j.W + (size_t)(k0 + (lane >> 5)) * j.ldw + n0 + (lane & 31);
#pragma unroll
    for (int i = 0; i < 32; ++i) wv[i] = wp[(size_t)(2 * i) * j.ldw];
    if (j.gk) {
#pragma unroll
        for (int i = 0; i < 32; ++i) wv[i] *= j.gk[k0 + 2 * i + (lane >> 5)]; }
#pragma unroll
    for (int i = 0; i < 32; ++i) scr[(2 * i + (lane >> 5)) * 33 + (lane & 31)] = wv[i];
    LDS_WAIT();
    const int c = lane & 7;
#pragma unroll
    for (int q = 0; q < 4; ++q) { const int n = (lane >> 3) + 8 * q; LAS const float* s = scr + (8 * c) * 33 + n;
        const int ng = n0 + n; const float sc = (ng >= j.n_lo && ng < j.n_hi) ? j.nscale : 1.f;
        u32x4 o; o.x = cvt_pk_bf16(s[0] * sc, s[33] * sc); o.y = cvt_pk_bf16(s[2 * 33] * sc, s[3 * 33] * sc); o.z = cvt_pk_bf16(s[4 * 33] * sc, s[5 * 33] * sc); o.w = cvt_pk_bf16(s[6 * 33] * sc, s[7 * 33] * sc);
        const int drow = j.rmode ? ((ng >> 7) * 256 + (ng & 127) + j.roff) : ng;
        *(u32x4*)(j.WT + (size_t)drow * j.ldt + k0 + 8 * c) = o; }
    LDS_WAIT();
}
__device__ __forceinline__ void phase_prep(CParams& P, LAS unsigned char* lds) {
    const int tid = get_tid(), wid = tid >> 6, lane = tid & 63;
    const int gw = get_bid() * 8 + wid, NGW = get_gdim() * 8;
    const int gt = get_bid() * 512 + tid, NGT = get_gdim() * 512;
    LAS float* scr = (LAS float*)(lds + wid * 8704);
#ifdef DEBUG_FILL
    { u32x4* bp = (u32x4*)(P.ws + WS_BIG); const size_t n16 = ((size_t)MTOK * AUW * 2) / 16; const u32x4 pv = (u32x4){DEBUG_FILL, DEBUG_FILL, DEBUG_FILL, DEBUG_FILL};
      for (size_t i = (size_t)get_bid() * 512 + tid; i < n16; i += (size_t)get_gdim() * 512) bp[i] = pv; }
#endif
    float* X = P.out; bf16_t* XB = (bf16_t*)(P.ws + WS_XB); float* SS = (float*)(P.ws + WS_SS);
    for (int row = gw; row < MTOK; row += NGW) {
        const float* src = row < MP ? P.in[0] + (size_t)row * 1024 : P.in[1] + (size_t)(row - MP) * 1024;
        float s = 0.f;
#pragma unroll
        for (int j = 0; j < 4; ++j) { const f32x4 v = *(const f32x4*)(src + 4 * lane + 256 * j);
            s += v[0] * v[0] + v[1] * v[1] + v[2] * v[2] + v[3] * v[3];
            u32x2 o; o.x = cvt_pk_bf16(v[0], v[1]); o.y = cvt_pk_bf16(v[2], v[3]); *(u32x2*)(XB + (size_t)row * 1024 + 4 * lane + 256 * j) = o; }
        s = wave_sum(s);
        if (lane < 16) SS[(size_t)lane * MTOK + row] = lane == 0 ? s : 0.f;
    }
    for (int it = gw; it < P.nitems; it += NGW) {
        int jb = 0;
#pragma unroll 1
        for (int q = 1; q < NJOBS; ++q) if (it >= P.jobs[q].item0) jb = q;
        transpose_item(P.jobs[jb], it - P.jobs[jb].item0, scr, lane);
    }
    float* WG = (float*)(P.ws + WS_WG);
    for (int i = gt; i < 2 * 8 * 1024; i += NGT) { const int e = i >> 13, j = (i >> 10) & 7, k = i & 1023;
        WG[i] = P.in[8][((size_t)e * 1024 + k) * 2568 + 2560 + j] * P.in[7][(2 * e) * 1024 + k]; }
    { bf16_t* WGB = (bf16_t*)(P.ws + WS_WGB);
      for (int i = gt; i < 2 * 16 * 1024 / 2; i += NGT) { const int i2 = i * 2, e = i2 >> 14, j = (i2 >> 10) & 15, k = i2 & 1023;
          float v0 = 0.f, v1 = 0.f;
          if (j < 8) { v0 = P.in[8][((size_t)e * 1024 + k) * 2568 + 2560 + j] * P.in[7][(2 * e) * 1024 + k]; v1 = P.in[8][((size_t)e * 1024 + k + 1) * 2568 + 2560 + j] * P.in[7][(2 * e) * 1024 + k + 1]; }
          *(unsigned*)(WGB + i2) = cvt_pk_bf16(v0, v1); } }
    bf16_t* WPOOL = (bf16_t*)(P.ws + WS_WPOOL);
    for (int i = gt; i < 2 * 4 * 128 * 128; i += NGT) { const int c = i & 127, d = (i >> 7) & 127, eg = i >> 14;
        const float mine = P.in[10][((size_t)eg * 128 + c) * 128 + d] * P.in[11][eg * 128 + d]; const float other = __shfl_xor(mine, 1);
        if (!(i & 1)) *(unsigned*)(WPOOL + i) = cvt_pk_bf16(mine, other); }
    bf16_t* WSP = (bf16_t*)(P.ws + WS_WSP);
    for (int i = gt; i < 2 * 4 * 128 * 128; i += NGT) { const int s = i & 127, r = (i >> 7) & 127;
        const float mine = s <= r ? P.in[17][i] : 0.f; const float other = __shfl_xor(mine, 1);
        if (!(i & 1)) *(unsigned*)(WSP + i) = cvt_pk_bf16(mine, other); }
}

__device__ __forceinline__ void phase_gates(CParams& P, int e, LAS unsigned char* lds) {
    const int tid = get_tid(), wid = tid >> 6, lane = tid & 63, fr = lane & 15, fq = lane >> 4;
    const bf16_t* XB = (const bf16_t*)(P.ws + WS_XB); const float* SS = (const float*)(P.ws + WS_SS); const bf16_t* WGB = (const bf16_t*)(P.ws + WS_WGB) + e * 16384;
    float* G = (float*)(P.ws + WS_BIG + B_GATES);
    LAS float* red = (LAS float*)lds;
    const int nbusy = (660 - 2 * get_gdim() > 0 && 660 - 2 * get_gdim() < get_gdim()) ? 660 - 2 * get_gdim() : 0;
    for (int u = get_bid() - nbusy; u < MTOK / 64; u += get_gdim() - nbusy) {
        if (u < 0) break;
        const int r0 = u * 64, k0 = wid * 128;
        f32x4 acc[4];
#pragma unroll
        for (int mi = 0; mi < 4; ++mi) acc[mi] = (f32x4){0.f, 0.f, 0.f, 0.f};
        bf16x8 a[4][4], b[4];
#pragma unroll
        for (int q = 0; q < 4; ++q) { b[q] = *(const bf16x8*)(WGB + (size_t)fr * 1024 + k0 + 32 * q + 8 * fq);
#pragma unroll
            for (int mi = 0; mi < 4; ++mi) a[q][mi] = *(const bf16x8*)(XB + (size_t)(r0 + 16 * mi + fr) * 1024 + k0 + 32 * q + 8 * fq); }
#pragma unroll
        for (int q = 0; q < 4; ++q)
#pragma unroll
            for (int mi = 0; mi < 4; ++mi) acc[mi] = __builtin_amdgcn_mfma_f32_16x16x32_bf16(a[q][mi], b[q], acc[mi], 0, 0, 0);
#pragma unroll
        for (int mi = 0; mi < 4; ++mi)
#pragma unroll
            for (int j = 0; j < 4; ++j) red[wid * 1024 + (16 * mi + 4 * fq + j) * 16 + fr] = acc[mi][j];
        __syncthreads();
        { const int row = tid >> 3, j = tid & 7;
          float v = 0.f;
#pragma unroll
          for (int w = 0; w < 8; ++w) v += red[w * 1024 + row * 16 + j];
          float s2 = 0.f;
#pragma unroll
          for (int q = 0; q < 16; ++q) s2 += SS[(size_t)q * MTOK + r0 + row];
          v = v * rsqrtf(s2 * (1.f / 1024.f) + EPS) + P.in[9][e * 8 + j];
          if (j >= 4) v = fminf(v, 0.f) - log1pf(__expf(-fabsf(v)));
          G[(size_t)(r0 + row) * 8 + j] = v; }
        __syncthreads();
    }
}

__device__ __forceinline__ void e2_unit(CParams& P, int unit, LAS unsigned char* lds) {
    const int tid = get_tid(), wid = tid >> 6, lane = tid & 63;
    const int b = unit >> 6, h = (unit >> 4) & 3, c = unit & 15;
    unsigned char* big = P.ws + WS_BIG;
    const bf16_t* ZB = (const bf16_t*)(big + B_ZB); const float* G = (const float*)(big + B_GATES);
    float* BT = (float*)(big + B_BT); float* SCAL = (float*)(big + B_SCAL); float* DC = (float*)(big + B_DC); float* DN = (float*)(big + B_DN);
    LAS bf16_t* VT = (LAS bf16_t*)lds; LAS bf16_t* KW = (LAS bf16_t*)(lds + TILE_B);
    LAS float* sB = (LAS float*)(lds + 2 * TILE_B); LAS float* sM = sB + 16; LAS float* sg = sB + 32; LAS float* sw = sB + 160;
    for (int cc = wid; cc <= c; cc += 8) {
        const size_t tb = (size_t)b * 2048 + cc * 128 + 2 * lane;
        const float lf0 = G[tb * 8 + 4 + h], lf1 = G[(tb + 1) * 8 + 4 + h], ig0 = G[tb * 8 + h], ig1 = G[(tb + 1) * 8 + h];
        const float pair = lf0 + lf1; float incl = pair;
#pragma unroll
        for (int o = 1; o < 64; o <<= 1) { const float t = __shfl_up(incl, o); if (lane >= o) incl += t; }
        const float b1 = incl, b0 = incl - lf1;
        const float Btot = __shfl(incl, 63);
        const float g0 = ig0 - b0, g1 = ig1 - b1; const float mx = wave_max(fmaxf(g0, g1));
        if (lane == 0) { sB[cc] = Btot; sM[cc] = Btot + mx; }
        if (cc == c) { sg[2 * lane] = g0; sg[2 * lane + 1] = g1; BT[tb * 4 + h] = b0; BT[(tb + 1) * 4 + h] = b1; }
    }
    __syncthreads();
    float m = 0.f, mprev = 0.f;
    for (int cc = 0; cc <= c; ++cc) { mprev = m; m = fmaxf(sB[cc] + m, sM[cc]); }
    const float Bc = sB[c];
    if (tid < 128) sw[tid] = __expf(Bc + sg[tid] - m);
    if (tid == 0) { SCAL[unit * 4 + 0] = mprev; SCAL[unit * 4 + 1] = m; SCAL[unit * 4 + 2] = Bc; }
    __syncthreads();
    const bf16_t* zrow = ZB + ((size_t)b * 2048 + c * 128) * NZ;
    stage_T<false>(VT, zrow + 1536 + h * 128, NZ, sw, wid, lane);
    stage_T<true>(KW, zrow + 1024 + h * 128, NZ, sw, wid, lane);
    __syncthreads();
    f32x4 acc[2][4]; zero_acc(acc);
    const int wr4 = wid >> 1, wc2 = wid & 1, fr = lane & 15, fq = lane >> 4;
    lds_gemm128(VT, KW, acc, wr4, wc2, lane);
    float* dc = DC + (size_t)unit * 16384;
#pragma unroll
    for (int mi = 0; mi < 2; ++mi)
#pragma unroll
        for (int ni = 0; ni < 4; ++ni)
#pragma unroll
            for (int j = 0; j < 4; ++j) dc[(32 * wr4 + 16 * mi + 4 * fq + j) * 128 + 64 * wc2 + 16 * ni + fr] = acc[mi][ni][j];
    if (tid < 128) { float s = 0.f;
#pragma unroll
        for (int i = 0; i < 16; ++i) { const u32x4 v = *(LAS const u32x4*)(KW + tid * LDP + 8 * i); float f[8]; unpack8(v, f);
#pragma unroll
            for (int q = 0; q < 8; ++q) s += f[q]; }
        DN[unit * 128 + tid] = s; }
    __syncthreads();
}

__device__ __forceinline__ void pool_unit(CParams& P, int e, int tile, int g, LAS unsigned char* lds) {
    const int tid = get_tid(), wid = tid >> 6, lane = tid & 63;
    unsigned char* big = P.ws + WS_BIG;
    const bf16_t* ZB = (const bf16_t*)(big + B_ZB); bf16_t* YMIX = (bf16_t*)(big + B_YMIX);
    const bf16_t* WPOOL = (const bf16_t*)(P.ws + WS_WPOOL) + (size_t)(e * 4 + g) * 16384;
    LAS bf16_t* A = (LAS bf16_t*)lds; LAS bf16_t* Bm = (LAS bf16_t*)(lds + TILE_B); LAS bf16_t* R = (LAS bf16_t*)(lds + 2 * TILE_B);
    const int w = 2 << g; const int tok0 = tile * 128;
    stage_rows(Bm, WPOOL, 128, tid);
    if (tile < 128) {
        const int tpos0 = tok0 & 2047;
        for (int idx = tid; idx < 143 * 16; idx += 512) { const int r = idx >> 4, ch = idx & 15;
            u32x4 v = (u32x4){0u, 0u, 0u, 0u};
            if (tpos0 - 15 + r >= 0) v = *(const u32x4*)(ZB + (size_t)(tok0 - 15 + r) * NZ + g * 128 + ch * 8);
            *(LAS u32x4*)(R + r * LDP + ch * 8) = v; }
        __syncthreads();
#pragma unroll 1
        for (int i = 0; i < 4; ++i) {
            const int idx = tid + 512 * i, t = idx >> 4, cg8 = idx & 15, tpos = tpos0 + t, col = g * 128 + cg8 * 8;
            float sum[8], self[8], f[8];
            unpack8(*(LAS const u32x4*)(R + (t + 15) * LDP + cg8 * 8), self);
#pragma unroll
            for (int q = 0; q < 8; ++q) sum[q] = self[q];
            for (int ii = 1; ii < w; ++ii) { unpack8(*(LAS const u32x4*)(R + (t + 15 - ii) * LDP + cg8 * 8), f);
#pragma unroll
                for (int q = 0; q < 8; ++q) sum[q] += f[q]; }
            if (tpos >= 2033) { float* o = P.out + O_POOLP + ((size_t)(e * 8 + (tok0 >> 11)) * 15 + (tpos - 2033)) * 512 + col;
                *(f32x4*)o = (f32x4){self[0], self[1], self[2], self[3]}; *(f32x4*)(o + 4) = (f32x4){self[4], self[5], self[6], self[7]}; }
            const float ic = 1.f / (float)min(w, tpos + 1); float d[8];
#pragma unroll
            for (int q = 0; q < 8; ++q) d[q] = sum[q] * ic - self[q];
            *(LAS u32x4*)(A + t * LDP + cg8 * 8) = pack8(d);
        }
    } else {
        const int seq = tid >> 4, cg8 = tid & 15, col = g * 128 + cg8 * 8; const int bs = ((tok0 - MP) >> 2) + seq;
        const float* sp = P.in[2] + ((size_t)(e * 128 + bs) * 15) * 512 + col;
        float* ob = P.out + O_POOLS + ((size_t)(e * 128 + bs) * 15) * 512 + col;
        float run[8], lo[4][8], hi[4][8], self[4][8];
#pragma unroll
        for (int q = 0; q < 8; ++q) { run[q] = 0.f;
#pragma unroll
            for (int t = 0; t < 4; ++t) lo[t][q] = 0.f; }
#pragma unroll
        for (int k = 0; k < 19; ++k) {
            float row[8];
            if (k < 15) { const f32x4 r0 = *(const f32x4*)(sp + (size_t)k * 512), r1 = *(const f32x4*)(sp + (size_t)k * 512 + 4);
                row[0] = r0[0]; row[1] = r0[1]; row[2] = r0[2]; row[3] = r0[3]; row[4] = r1[0]; row[5] = r1[1]; row[6] = r1[2]; row[7] = r1[3]; }
            else unpack8(*(const u32x4*)(ZB + (size_t)(MP + bs * 4 + (k - 15)) * NZ + col), row);
            if (k >= 4) { float* o = ob + (size_t)(k - 4) * 512; *(f32x4*)o = (f32x4){row[0], row[1], row[2], row[3]}; *(f32x4*)(o + 4) = (f32x4){row[4], row[5], row[6], row[7]}; }
#pragma unroll
            for (int q = 0; q < 8; ++q) run[q] += row[q];
#pragma unroll
            for (int t = 0; t < 4; ++t) {
                if (k == 15 + t - w) {
#pragma unroll
                    for (int q = 0; q < 8; ++q) lo[t][q] = run[q]; }
                if (k == 15 + t) {
#pragma unroll
                    for (int q = 0; q < 8; ++q) { hi[t][q] = run[q]; self[t][q] = row[q]; } }
            }
        }
        const float ic = 1.f / (float)w;
#pragma unroll
        for (int t = 0; t < 4; ++t) { float d[8];
#pragma unroll
            for (int q = 0; q < 8; ++q) d[q] = (hi[t][q] - lo[t][q]) * ic - self[t][q];
            *(LAS u32x4*)(A + (seq * 4 + t) * LDP + cg8 * 8) = pack8(d); }
    }
    __syncthreads();
    f32x4 acc[2][4]; zero_acc(acc);
    const int wr4 = wid >> 1, wc2 = wid & 1, fr = lane & 15, fq = lane >> 4;
    lds_gemm128(A, Bm, acc, wr4, wc2, lane);
#pragma unroll
    for (int mi = 0; mi < 2; ++mi)
#pragma unroll
        for (int ni = 0; ni < 4; ++ni)
#pragma unroll
            for (int j = 0; j < 4; ++j) { const float mine = acc[mi][ni][j]; const float other = __shfl_xor(mine, 1);
                if (!(fr & 1)) *(unsigned*)(YMIX + (size_t)(tok0 + 32 * wr4 + 16 * mi + 4 * fq + j) * 1024 + g * 128 + 64 * wc2 + 16 * ni + fr) = cvt_pk_bf16(mine, other); }
    __syncthreads();
}

__device__ __forceinline__ void phase_scan(CParams& P, int e) {
    unsigned char* big = P.ws + WS_BIG;
    const float* SCAL = (const float*)(big + B_SCAL); const float* DC = (const float*)(big + B_DC); const float* DN = (const float*)(big + B_DN);
    bf16_t* CPREV = (bf16_t*)(big + B_CPREV); float* NPREV = (float*)(big + B_NPREV);
    const int gt = get_bid() * 512 + get_tid(), NGT = get_gdim() * 512;
    for (int i = gt; i < 32 * 4096; i += NGT) {
        const int bh = i >> 12, e4 = (i & 4095) * 4;
        f32x4 st = (f32x4){0.f, 0.f, 0.f, 0.f}; f32x4 dcv[16]; float aLv[16];
#pragma unroll
        for (int c = 0; c < 16; ++c) { const int unit = bh * 16 + c; dcv[c] = *(const f32x4*)(DC + (size_t)unit * 16384 + e4);
            aLv[c] = __expf(SCAL[unit * 4 + 2] + SCAL[unit * 4 + 0] - SCAL[unit * 4 + 1]); }
#pragma unroll
        for (int c = 0; c < 16; ++c) {
            const int unit = bh * 16 + c;
            u32x2 o; o.x = cvt_pk_bf16(st[0], st[1]); o.y = cvt_pk_bf16(st[2], st[3]); *(u32x2*)(CPREV + (size_t)unit * 16384 + e4) = o;
            st = st * aLv[c] + dcv[c];
        }
        const int v = e4 >> 7, k = e4 & 127;
        float* o = P.out + O_CP + ((size_t)(e * 32 + bh) * 128) * 128;
#pragma unroll
        for (int q = 0; q < 4; ++q) o[(size_t)(k + q) * 128 + v] = st[q];
    }
    for (int i = gt; i < 32 * 128; i += NGT) {
        const int bh = i >> 7, k = i & 127; float st = 0.f;
        for (int c = 0; c < 16; ++c) { const int unit = bh * 16 + c; NPREV[unit * 128 + k] = st;
            const float aL = __expf(SCAL[unit * 4 + 2] + SCAL[unit * 4 + 0] - SCAL[unit * 4 + 1]); st = st * aL + DN[unit * 128 + k]; }
        P.out[O_NP + (size_t)(e * 32 + bh) * 128 + k] = st;
    }
    if (gt < 32) P.out[O_MP + e * 32 + gt] = SCAL[(gt * 16 + 15) * 4 + 1];
}
__device__ __forceinline__ void mlstm_sample_unit(CParams& P, int e, int unit, LAS unsigned char* lds) {
    const int tid = get_tid(), lane = tid & 63;
    const int bs = unit >> 2, h = unit & 3; const int tokS = MP + bs * 4;
    unsigned char* big = P.ws + WS_BIG;
    const bf16_t* ZB = (const bf16_t*)(big + B_ZB); const float* G = (const float*)(big + B_GATES); bf16_t* YMIX = (bf16_t*)(big + B_YMIX);
    LAS float* sq = (LAS float*)lds; LAS float* sk = sq + 512; LAS float* sv = sq + 1024; LAS float* swk = sq + 1536; LAS float* sqc = sq + 2048;
    LAS float* sS = sq + 4096; LAS float* sqn = sS + 16; LAS float* shs = sqn + 4;
    const size_t sidx = (size_t)(e * 128 + bs) * 4 + h;
    const float* C0 = P.in[3] + sidx * 16384; const float* n0 = P.in[4] + sidx * 128; const float m0 = P.in[5][sidx];
    for (int idx = tid; idx < 1536; idx += 512) { const int which = idx >> 9, t = (idx >> 7) & 3, f = idx & 127;
        sq[idx] = bf2f(ZB[(size_t)(tokS + t) * NZ + 512 + which * 512 + h * 128 + f]); }
    float ig[4], bb[4], mt[4], at[4]; float cs = 0.f;
#pragma unroll
    for (int t = 0; t < 4; ++t) { ig[t] = G[(size_t)(tokS + t) * 8 + h]; cs += G[(size_t)(tokS + t) * 8 + 4 + h]; bb[t] = cs; }
#pragma unroll
    for (int t = 0; t < 4; ++t) { float mm = bb[t] + m0;
#pragma unroll
        for (int s = 0; s < 4; ++s) if (s <= t) mm = fmaxf(mm, bb[t] - bb[s] + ig[s]);
        mt[t] = mm; at[t] = __expf(bb[t] + m0 - mm); }
    const float mnew = mt[3]; const float aL = __expf(bb[3] + m0 - mnew);
    float ws[4];
#pragma unroll
    for (int s = 0; s < 4; ++s) ws[s] = __expf(bb[3] - bb[s] + ig[s] - mnew);
    __syncthreads();
    {
        const int p = tid >> 5, l32 = tid & 31, t = p >> 2, s = p & 3;
        float d = 0.f;
#pragma unroll
        for (int q = 0; q < 4; ++q) d += sq[t * 128 + l32 * 4 + q] * sk[s * 128 + l32 * 4 + q];
#pragma unroll
        for (int o = 1; o < 32; o <<= 1) d += __shfl_xor(d, o);
        float bt = 0.f, bsv = 0.f, igs = 0.f, mtt = 0.f;
#pragma unroll
        for (int q = 0; q < 4; ++q) { if (q == t) { bt = bb[q]; mtt = mt[q]; } if (q == s) { bsv = bb[q]; igs = ig[q]; } }
        if (l32 == 0) sS[p] = (s <= t) ? d * __expf(bt - bsv + igs - mtt) : 0.f;
        if (p < 4) { float d2 = 0.f;
#pragma unroll
            for (int q = 0; q < 4; ++q) d2 += sq[p * 128 + l32 * 4 + q] * n0[l32 * 4 + q];
#pragma unroll
            for (int o = 1; o < 32; o <<= 1) d2 += __shfl_xor(d2, o);
            if (l32 == 0) sqn[p] = d2; }
        const int s2 = tid >> 7, k2 = tid & 127; float wv = 0.f;
#pragma unroll
        for (int q = 0; q < 4; ++q) if (q == s2) wv = ws[q];
        swk[tid] = wv * sk[s2 * 128 + k2];
    }
    __syncthreads();
    {
        const int v = tid & 127, kq = tid >> 7; float qc[4] = {0.f, 0.f, 0.f, 0.f};
        float* Co = P.out + O_CS + sidx * 16384;
        const float v0 = sv[v], v1 = sv[128 + v], v2 = sv[256 + v], v3 = sv[384 + v];
#pragma unroll 1
        for (int kb = 0; kb < 32; kb += 16) {
            float c0v[16];
#pragma unroll
            for (int kk = 0; kk < 16; ++kk) c0v[kk] = C0[(kq * 32 + kb + kk) * 128 + v];
#pragma unroll
            for (int kk = 0; kk < 16; ++kk) { const int k = kq * 32 + kb + kk; const float c0 = c0v[kk];
                Co[k * 128 + v] = aL * c0 + swk[k] * v0 + swk[128 + k] * v1 + swk[256 + k] * v2 + swk[384 + k] * v3;
#pragma unroll
                for (int t = 0; t < 4; ++t) qc[t] += sq[t * 128 + k] * c0; }
        }
#pragma unroll
        for (int t = 0; t < 4; ++t) sqc[(kq * 4 + t) * 128 + v] = qc[t];
        if (tid < 128) P.out[O_NS + sidx * 128 + tid] = aL * n0[tid] + swk[tid] + swk[128 + tid] + swk[256 + tid] + swk[384 + tid];
        if (tid == 0) P.out[O_MS + sidx] = mnew;
    }
    __syncthreads();
    const int t = tid >> 7, v = tid & 127;
    float att = 0.f, mtt = 0.f;
#pragma unroll
    for (int q = 0; q < 4; ++q) if (q == t) { att = at[q]; mtt = mt[q]; }
    const float qC = sqc[(0 * 4 + t) * 128 + v] + sqc[(1 * 4 + t) * 128 + v] + sqc[(2 * 4 + t) * 128 + v] + sqc[(3 * 4 + t) * 128 + v];
    float den = att * sqn[t], num = att * qC;
#pragma unroll
    for (int s = 0; s < 4; ++s) { const float Sv = sS[t * 4 + s]; den += Sv; num += Sv * sv[s * 128 + v]; }
    const float hv = num / fmaxf(fabsf(den), __expf(-mtt));
    const float hsq = wave_sum(hv * hv);
    if (lane == 0) shs[t * 2 + ((tid >> 6) & 1)] = hsq;
    __syncthreads();
    const float rn = rsqrtf((shs[t * 2] + shs[t * 2 + 1]) * (1.f / 128.f) + EPS);
    const int col = h * 128 + v;
    const float o = bf2f(ZB[(size_t)(tokS + t) * NZ + 2048 + col]);
    { const float mine = sigmoidf_(o) * hv * rn * P.in[12][e * 512 + col]; const float other = __shfl_xor(mine, 1);
      if (!(v & 1)) *(unsigned*)(YMIX + (size_t)(tokS + t) * 1024 + 512 + col) = cvt_pk_bf16(mine, other); }
    __syncthreads();
}

__device__ __forceinline__ void e4_unit(CParams& P, int e, int unit, LAS unsigned char* lds) {
    const int tid = get_tid(), wid = tid >> 6, lane = tid & 63;
    const int b = unit >> 6, h = (unit >> 4) & 3, c = unit & 15; const int tok0 = b * 2048 + c * 128;
    unsigned char* big = P.ws + WS_BIG;
    const bf16_t* ZB = (const bf16_t*)(big + B_ZB); const float* G = (const float*)(big + B_GATES);
    const float* BT = (const float*)(big + B_BT); const float* SCAL = (const float*)(big + B_SCAL);
    const bf16_t* CPREV = (const bf16_t*)(big + B_CPREV); const float* NPREV = (const float*)(big + B_NPREV); bf16_t* YMIX = (bf16_t*)(big + B_YMIX);
    LAS bf16_t* Q = (LAS bf16_t*)lds; LAS bf16_t* Kb = (LAS bf16_t*)(lds + TILE_B); LAS bf16_t* VT = (LAS bf16_t*)(lds + 2 * TILE_B); LAS bf16_t* CT = (LAS bf16_t*)(lds + 3 * TILE_B);
    LAS float* sm = (LAS float*)(lds + 4 * TILE_B);
    LAS float* sgs = sm; LAS float* smt = sm + 128; LAS float* set = sm + 256; LAS float* sat = sm + 384; LAS float* rsum = sm + 512  ;
    LAS float* hs = sm + 768  ; LAS float* sdinv = sm + 1024; LAS float* sqn = sm + 1152; LAS float* snp = sm + 1280; LAS float* sbt = sm + 1408;
    const bf16_t* zrow = ZB + (size_t)tok0 * NZ;
    stage_rows(Q, zrow + 512 + h * 128, NZ, tid);
    stage_rows(Kb, zrow + 1024 + h * 128, NZ, tid);
    stage_T<false>(VT, zrow + 1536 + h * 128, NZ, sm, wid, lane);
    stage_rows(CT, CPREV + (size_t)unit * 16384, 128, tid);
    const float mprev = SCAL[unit * 4 + 0];
    if (tid < 128) { const float bt = BT[(size_t)(tok0 + tid) * 4 + h], igv = G[(size_t)(tok0 + tid) * 8 + h]; sbt[tid] = bt; sgs[tid] = igv - bt; snp[tid] = NPREV[unit * 128 + tid]; }
    __syncthreads();
    if (tid < 128) {
        float cm = sgs[tid];
#pragma unroll
        for (int o = 1; o < 64; o <<= 1) { const float t2 = __shfl_up(cm, o); if (lane >= o) cm = fmaxf(cm, t2); }
        if (tid >= 64) { float m0 = sgs[lane]; m0 = wave_max(m0); cm = fmaxf(cm, m0); }
        const float bt = sbt[tid]; const float mt = bt + fmaxf(mprev, cm);
        smt[tid] = mt; set[tid] = bt - mt; sat[tid] = __expf(bt + mprev - mt);
        float qn = 0.f;
#pragma unroll
        for (int i = 0; i < 16; ++i) { float f[8]; unpack8(*(LAS const u32x4*)(Q + tid * LDP + 8 * i), f);
#pragma unroll
            for (int q = 0; q < 8; ++q) qn += f[q] * snp[8 * i + q]; }
        sqn[tid] = qn;
    }
    const int wr4 = wid >> 1, wc2 = wid & 1, fr = lane & 15, fq = lane >> 4;
    f32x4 acc1[2][4]; zero_acc(acc1);
    lds_gemm128(Q, Kb, acc1, wr4, wc2, lane);
    __syncthreads();
#pragma unroll
    for (int mi = 0; mi < 2; ++mi)
#pragma unroll
        for (int j = 0; j < 4; ++j) {
            const int t = 32 * wr4 + 16 * mi + 4 * fq + j; const float et = set[t]; float rs = 0.f;
#pragma unroll
            for (int ni = 0; ni < 4; ++ni) { const int s = 64 * wc2 + 16 * ni + fr;
                const float p = (s <= t) ? acc1[mi][ni][j] * __expf(et + sgs[s]) : 0.f; rs += p; const float po = __shfl_xor(p, 1);
                if (!(fr & 1)) *(LAS unsigned*)(Kb + t * LDP + s) = cvt_pk_bf16(p, po); }
            rs += __shfl_xor(rs, 1); rs += __shfl_xor(rs, 2); rs += __shfl_xor(rs, 4); rs += __shfl_xor(rs, 8);
            if (fr == 0) rsum[wc2 * 128 + t] = rs;
        }
    __syncthreads();
    if (tid < 128) { const float den = sat[tid] * sqn[tid] + rsum[tid] + rsum[128 + tid]; sdinv[tid] = 1.f / fmaxf(fabsf(den), __expf(-smt[tid])); }
    f32x4 acc2[2][4]; zero_acc(acc1); zero_acc(acc2);
    bf16_t og[2][4][4]; float gh[4];
#pragma unroll
    for (int ni = 0; ni < 4; ++ni) gh[ni] = P.in[12][e * 512 + h * 128 + 64 * wc2 + 16 * ni + fr];
#pragma unroll
    for (int mi = 0; mi < 2; ++mi)
#pragma unroll
        for (int j = 0; j < 4; ++j)
#pragma unroll
            for (int ni = 0; ni < 4; ++ni) og[mi][j][ni] = ZB[(size_t)(tok0 + 32 * wr4 + 16 * mi + 4 * fq + j) * NZ + 2048 + h * 128 + 64 * wc2 + 16 * ni + fr];
    lds_gemm128(Kb, VT, acc1, wr4, wc2, lane);
    lds_gemm128(Q, CT, acc2, wr4, wc2, lane);
    __syncthreads();
#pragma unroll
    for (int mi = 0; mi < 2; ++mi)
#pragma unroll
        for (int j = 0; j < 4; ++j) {
            const int t = 32 * wr4 + 16 * mi + 4 * fq + j; const float a = sat[t], di = sdinv[t]; float sq = 0.f;
#pragma unroll
            for (int ni = 0; ni < 4; ++ni) { const float hv = (a * acc2[mi][ni][j] + acc1[mi][ni][j]) * di; acc1[mi][ni][j] = hv; sq += hv * hv; }
            sq += __shfl_xor(sq, 1); sq += __shfl_xor(sq, 2); sq += __shfl_xor(sq, 4); sq += __shfl_xor(sq, 8);
            if (fr == 0) hs[wc2 * 128 + t] = sq;
        }
    __syncthreads();
#pragma unroll
    for (int mi = 0; mi < 2; ++mi)
#pragma unroll
        for (int j = 0; j < 4; ++j) {
            const int t = 32 * wr4 + 16 * mi + 4 * fq + j; const float rn = rsqrtf((hs[t] + hs[128 + t]) * (1.f / 128.f) + EPS);
#pragma unroll
            for (int ni = 0; ni < 4; ++ni) { const int col = h * 128 + 64 * wc2 + 16 * ni + fr;
                const float mine = sigmoidf_(bf2f(og[mi][j][ni])) * acc1[mi][ni][j] * rn * gh[ni]; const float other = __shfl_xor(mine, 1);
                if (!(fr & 1)) *(unsigned*)(YMIX + (size_t)(tok0 + t) * 1024 + 512 + col) = cvt_pk_bf16(mine, other); }
        }
    __syncthreads();
}

__device__ __forceinline__ void sgu_unit(CParams& P, int o, int unit, LAS unsigned char* lds) {
    const int tid = get_tid(), wid = tid >> 6, lane = tid & 63;
    const int g = unit & 3, tile = unit >> 2; const int tok0 = tile * 128;
    unsigned char* big = P.ws + WS_BIG;
    const bf16_t* U = (const bf16_t*)(big + B_U); const bf16_t* VPRE = (const bf16_t*)(big + B_VPRE); const float* LNS = (const float*)(big + B_LNS); bf16_t* US = (bf16_t*)(big + B_US);
    const bf16_t* WSP = (const bf16_t*)(P.ws + WS_WSP) + (size_t)(o * 4 + g) * 16384;
    LAS bf16_t* A = (LAS bf16_t*)lds; LAS bf16_t* B0 = (LAS bf16_t*)(lds + TILE_B); LAS bf16_t* B1 = (LAS bf16_t*)(lds + 2 * TILE_B);
    LAS float* smu = (LAS float*)(lds + 3 * TILE_B); LAS float* srs = smu + 128;
    stage_rows(A, WSP, 128, tid);
    if (tid < 128) { float s = 0.f, q = 0.f;
#pragma unroll
        for (int j = 0; j < 16; ++j) { s += LNS[(size_t)j * MTOK + tok0 + tid]; q += LNS[(size_t)(16 + j) * MTOK + tok0 + tid]; }
        const float mu = s * (1.f / 1024.f); smu[tid] = mu; srs[tid] = rsqrtf(fmaxf(q * (1.f / 1024.f) - mu * mu, 0.f) + EPS); }
    __syncthreads();
    {
        const int t0 = 2 * lane; const float mu0 = smu[t0], mu1 = smu[t0 + 1], r0 = srs[t0], r1 = srs[t0 + 1];
#pragma unroll
        for (int half = 0; half < 2; ++half) {
            LAS bf16_t* dst = half ? B1 : B0;
#pragma unroll
            for (int it = 0; it < 2; ++it) {
                const int fg = wid + 8 * it; const int ch0 = g * 256 + half * 128 + fg * 8;
                float fa[8], fb[8];
                unpack8(*(const u32x4*)(VPRE + (size_t)(tok0 + t0) * 1024 + ch0), fa); unpack8(*(const u32x4*)(VPRE + (size_t)(tok0 + t0 + 1) * 1024 + ch0), fb);
                const f32x4 lg0 = *(const f32x4*)(P.in[15] + o * 1024 + ch0), lg1 = *(const f32x4*)(P.in[15] + o * 1024 + ch0 + 4), lb0 = *(const f32x4*)(P.in[16] + o * 1024 + ch0), lb1 = *(const f32x4*)(P.in[16] + o * 1024 + ch0 + 4);
#pragma unroll
                for (int q = 0; q < 8; ++q) { const float lg = q < 4 ? lg0[q & 3] : lg1[q & 3], lb = q < 4 ? lb0[q & 3] : lb1[q & 3];
                    *(LAS unsigned*)(dst + (8 * fg + q) * LDP + t0) = cvt_pk_bf16((fa[q] - mu0) * r0 * lg + lb, (fb[q] - mu1) * r1 * lg + lb); }
            }
        }
    }
    __syncthreads();
    const int wr4 = wid >> 1, wc2 = wid & 1, fr = lane & 15, fq = lane >> 4;
    f32x4 acc0[2][4], acc1[2][4]; zero_acc(acc0); zero_acc(acc1);
    lds_gemm128(A, B0, acc0, wr4, wc2, lane);
    lds_gemm128(A, B1, acc1, wr4, wc2, lane);
    __syncthreads();
#pragma unroll
    for (int mi = 0; mi < 2; ++mi)
#pragma unroll
        for (int j = 0; j < 4; ++j) { const int r = 32 * wr4 + 16 * mi + 4 * fq + j; const float bsv = P.in[18][(o * 4 + g) * 128 + r];
#pragma unroll
            for (int ni = 0; ni < 4; ++ni) { const int d = 64 * wc2 + 16 * ni + fr;
                lds_put_pair(B0, r, d, fr, acc0[mi][ni][j] + bsv); lds_put_pair(B1, r, d, fr, acc1[mi][ni][j] + bsv); } }
    __syncthreads();
    {
        u32x4 uraw[8];
#pragma unroll
        for (int i = 0; i < 8; ++i) { const int idx = tid + 512 * i, r = idx >> 5, ch = idx & 31; uraw[i] = *(const u32x4*)(U + (size_t)(tok0 + r) * 1024 + g * 256 + ch * 8); }
#pragma unroll
        for (int i = 0; i < 8; ++i) { const int idx = tid + 512 * i, r = idx >> 5, ch = idx & 31;
            float uf[8], sf[8]; unpack8(uraw[i], uf); unpack8(*(LAS const u32x4*)((ch < 16 ? B0 : B1) + r * LDP + (ch & 15) * 8), sf);
#pragma unroll
            for (int q = 0; q < 8; ++q) uf[q] *= sf[q];
            *(u32x4*)(US + (size_t)(tok0 + r) * 1024 + g * 256 + ch * 8) = pack8(uf); }
    }
    __syncthreads();
}
__device__ __forceinline__ void sgu_sample(CParams& P, int o) {
    const int tid = get_tid(), wid = tid >> 6, lane = tid & 63;
    const int gw = get_bid() * 8 + wid, NGW = get_gdim() * 8;
    unsigned char* big = P.ws + WS_BIG;
    const bf16_t* U = (const bf16_t*)(big + B_U); const bf16_t* VPRE = (const bf16_t*)(big + B_VPRE); const float* LNS = (const float*)(big + B_LNS); bf16_t* US = (bf16_t*)(big + B_US);
    for (int bs = gw; bs < 128; bs += NGW) {
        const int tokS = MP + bs * 4; float mu[4], rs[4];
#pragma unroll
        for (int t = 0; t < 4; ++t) { float s = lane < 16 ? LNS[(size_t)lane * MTOK + tokS + t] : 0.f, q = lane < 16 ? LNS[(size_t)(16 + lane) * MTOK + tokS + t] : 0.f;
            s = wave_sum(s); q = wave_sum(q); mu[t] = s * (1.f / 1024.f); rs[t] = rsqrtf(fmaxf(q * (1.f / 1024.f) - mu[t] * mu[t], 0.f) + EPS); }
        for (int i = 0; i < 16; ++i) { const int d = lane + 64 * i, g = d >> 8; const float lg = P.in[15][o * 1024 + d], lb = P.in[16][o * 1024 + d];
            float vl[4];
#pragma unroll
            for (int t = 0; t < 4; ++t) { vl[t] = (bf2f(VPRE[(size_t)(tokS + t) * 1024 + d]) - mu[t]) * rs[t] * lg + lb;
                P.out[O_V + ((size_t)(o * 128 + bs) * 4 + t) * 1024 + d] = vl[t]; }
#pragma unroll
            for (int t = 0; t < 4; ++t) { float s = P.in[18][(o * 4 + g) * 128 + t];
#pragma unroll
                for (int s2 = 0; s2 < 4; ++s2) if (s2 <= t) s += P.in[17][((size_t)(o * 4 + g) * 128 + t) * 128 + s2] * vl[s2];
                const float mine = bf2f(U[(size_t)(tokS + t) * 1024 + d]) * s; const float other = __shfl_xor(mine, 1);
                if (!(lane & 1)) *(unsigned*)(US + (size_t)(tokS + t) * 1024 + d) = cvt_pk_bf16(mine, other); }
        }
    }
}

__device__ __forceinline__ void conv_item(const float (&e0)[8], const float (&e1)[8], const float (&a2)[8], const float (&uu)[8], LAS const float* wl, int n, bf16_t* dst) {
    float gq[8];
#pragma unroll
    for (int h4 = 0; h4 < 2; ++h4) {
        const f32x4 w0 = *(LAS const f32x4*)(wl + n + 4 * h4), w1 = *(LAS const f32x4*)(wl + FF + n + 4 * h4), w2 = *(LAS const f32x4*)(wl + 2 * FF + n + 4 * h4), cb = *(LAS const f32x4*)(wl + 3 * FF + n + 4 * h4);
#pragma unroll
        for (int q = 0; q < 4; ++q) { const int i = 4 * h4 + q; const float ac = cb[q] + w0[q] * e0[i] + w1[q] * e1[i] + w2[q] * a2[i]; gq[i] = gelu_t(ac) * uu[i]; }
    }
    *(u32x4*)dst = pack8(gq);
}
__device__ __forceinline__ void phase_conv(CParams& P, int l, LAS unsigned char* lds) {
    unsigned char* big = P.ws + WS_BIG;
    bf16_t* Gb = (bf16_t*)(big + B_G); bf16_t* AUS = (bf16_t*)(big + B_AUS);
    const float* HF = (const float*)(big + B_HF); const float* HU = (const float*)(big + B_HU); const float* HL = (const float*)(big + B_HL);
    const int tid = get_tid();
    const int gt = get_bid() * 512 + tid, NGT = get_gdim() * 512;
    LAS float* wl = (LAS float*)lds;
    for (int i = tid; i < 3 * FF; i += 512) wl[i] = P.in[23][(size_t)l * 3 * FF + i];
    for (int i = tid; i < FF; i += 512) wl[3 * FF + i] = P.in[24][(size_t)l * FF + i];
    __syncthreads();
    for (int it = gt; it < 256 * 2 * 352; it += NGT) {
        const int c8 = it % 352, i = (it / 352) & 1, rb = it / 704, n = c8 * 8;
        float a2[8], uu[8], e0[8], e1[8];
        { const float* p = HF + ((size_t)rb * 2 + i) * FF + n; const f32x4 x0 = *(const f32x4*)p, x1 = *(const f32x4*)(p + 4);
          a2[0] = x0[0]; a2[1] = x0[1]; a2[2] = x0[2]; a2[3] = x0[3]; a2[4] = x1[0]; a2[5] = x1[1]; a2[6] = x1[2]; a2[7] = x1[3]; }
        { const float* p = HU + ((size_t)rb * 2 + i) * FF + n; const f32x4 x0 = *(const f32x4*)p, x1 = *(const f32x4*)(p + 4);
          uu[0] = x0[0]; uu[1] = x0[1]; uu[2] = x0[2]; uu[3] = x0[3]; uu[4] = x1[0]; uu[5] = x1[1]; uu[6] = x1[2]; uu[7] = x1[3]; }
        const bool first = (rb & 31) == 0;
        const float* p1 = i == 0 ? (first ? nullptr : HL + ((size_t)(rb - 1) * 2 + 1) * FF + n) : HF + ((size_t)rb * 2) * FF + n;
        const float* p0 = i == 0 ? (first ? nullptr : HL + ((size_t)(rb - 1) * 2 + 0) * FF + n) : (first ? nullptr : HL + ((size_t)(rb - 1) * 2 + 1) * FF + n);
#pragma unroll
        for (int q = 0; q < 8; ++q) { e1[q] = 0.f; e0[q] = 0.f; }
        if (p1) { const f32x4 x0 = *(const f32x4*)p1, x1 = *(const f32x4*)(p1 + 4); e1[0] = x0[0]; e1[1] = x0[1]; e1[2] = x0[2]; e1[3] = x0[3]; e1[4] = x1[0]; e1[5] = x1[1]; e1[6] = x1[2]; e1[7] = x1[3]; }
        if (p0) { const f32x4 x0 = *(const f32x4*)p0, x1 = *(const f32x4*)(p0 + 4); e0[0] = x0[0]; e0[1] = x0[1]; e0[2] = x0[2]; e0[3] = x0[3]; e0[4] = x1[0]; e0[5] = x1[1]; e0[6] = x1[2]; e0[7] = x1[3]; }
        conv_item(e0, e1, a2, uu, wl, n, Gb + ((size_t)rb * 64 + i) * FF + n);
    }
    for (int it = gt; it < 8 * 2 * 704; it += NGT) { const int c4 = (it % 704) * 4, j = (it / 704) & 1, b = it / 1408;
        *(f32x4*)(P.out + O_CONVP + ((size_t)(l * 8 + b) * 2 + j) * FF + c4) = *(const f32x4*)(HL + ((size_t)(b * 32 + 31) * 2 + j) * FF + c4); }
    for (int it = gt; it < 512 * 352; it += NGT) {
        const int srow = it / 352, n = (it % 352) * 8;
        const bf16_t* row = AUS + (size_t)srow * AUW;
        float a2[8], uu[8], e0[8], e1[8];
        unpack8(*(const u32x4*)(row + n), a2); unpack8(*(const u32x4*)(row + FF + n), uu);
        const int bs = srow >> 2, t = srow & 3;
        const float* sb = P.in[6] + ((size_t)(l * 128 + bs) * 2) * FF + n;
        if (t >= 1) unpack8(*(const u32x4*)(row - AUW + n), e1); else { const f32x4 x0 = *(const f32x4*)(sb + FF), x1 = *(const f32x4*)(sb + FF + 4);
            e1[0] = x0[0]; e1[1] = x0[1]; e1[2] = x0[2]; e1[3] = x0[3]; e1[4] = x1[0]; e1[5] = x1[1]; e1[6] = x1[2]; e1[7] = x1[3]; }
        if (t >= 2) unpack8(*(const u32x4*)(row - 2 * AUW + n), e0); else { const float* s2 = sb + (t == 0 ? 0 : FF); const f32x4 x0 = *(const f32x4*)s2, x1 = *(const f32x4*)(s2 + 4);
            e0[0] = x0[0]; e0[1] = x0[1]; e0[2] = x0[2]; e0[3] = x0[3]; e0[4] = x1[0]; e0[5] = x1[1]; e0[6] = x1[2]; e0[7] = x1[3]; }
        if (t >= 2) { float* o = P.out + O_CONVS + ((size_t)(l * 128 + bs) * 2 + (t - 2)) * FF + n;
            *(f32x4*)o = (f32x4){a2[0], a2[1], a2[2], a2[3]}; *(f32x4*)(o + 4) = (f32x4){a2[4], a2[5], a2[6], a2[7]}; }
        conv_item(e0, e1, a2, uu, wl, n, Gb + (size_t)(MP + srow) * FF + n);
    }
}

__device__ __forceinline__ void phase_final(CParams& P) {
    const int tid = get_tid(), wid = tid >> 6, lane = tid & 63;
    const int gw = get_bid() * 8 + wid, NGW = get_gdim() * 8;
    float* X = P.out; const bf16_t* XB = (const bf16_t*)(P.ws + WS_XB); const float* SS = (const float*)(P.ws + WS_SS); const float* gf = P.in[26];
    for (int row = gw; row < MTOK; row += NGW) {
        float s = lane < 16 ? SS[(size_t)lane * MTOK + row] : 0.f; s = wave_sum(s);
        const float rstd = rsqrtf(s * (1.f / 1024.f) + EPS);
#pragma unroll
        for (int j = 0; j < 4; ++j) { float* p = X + (size_t)row * 1024 + 4 * lane + 256 * j; const u32x2 xr = *(const u32x2*)(XB + (size_t)row * 1024 + 4 * lane + 256 * j);
            const f32x4 v = (f32x4){bflo(xr.x), bfhi(xr.x), bflo(xr.y), bfhi(xr.y)}, gg = *(const f32x4*)(gf + 4 * lane + 256 * j);
            *(f32x4*)p = v * rstd * gg; }
    }
}

__device__ __forceinline__ void small_resid_unit(const bf16_t* A, int lda, const bf16_t* Bt, int ldb, int K, int r0, int c0, bf16_t* XB, float* ss, LAS unsigned char* lds) {
    const int tid = get_tid(), wid = tid >> 6, lane = tid & 63, fr = lane & 15, fq = lane >> 4;
    LAS float* red = (LAS float*)lds;
    const int kw = K >> 3, k0 = wid * kw, nsteps = kw >> 5;
    const bf16_t* ap = A + (size_t)(r0 + fr) * lda + k0 + 8 * fq;
    const bf16_t* bp = Bt + (size_t)(c0 + fr) * ldb + k0 + 8 * fq;
    f32x4 acc[4][4];
#pragma unroll
    for (int mi = 0; mi < 4; ++mi)
#pragma unroll
        for (int ni = 0; ni < 4; ++ni) acc[mi][ni] = (f32x4){0.f, 0.f, 0.f, 0.f};
    bf16x8 a[2][4], b[2][4];
#pragma unroll
    for (int i = 0; i < 4; ++i) { a[0][i] = *(const bf16x8*)(ap + (size_t)(16 * i) * lda); b[0][i] = *(const bf16x8*)(bp + (size_t)(16 * i) * ldb); }
#pragma unroll 1
    for (int st = 0; st < nsteps; st += 2) {
        if (st + 1 < nsteps) {
#pragma unroll
            for (int i = 0; i < 4; ++i) { a[1][i] = *(const bf16x8*)(ap + (size_t)(16 * i) * lda + 32 * (st + 1)); b[1][i] = *(const bf16x8*)(bp + (size_t)(16 * i) * ldb + 32 * (st + 1)); } }
#pragma unroll
        for (int mi = 0; mi < 4; ++mi)
#pragma unroll
            for (int ni = 0; ni < 4; ++ni) acc[mi][ni] = __builtin_amdgcn_mfma_f32_16x16x32_bf16(a[0][mi], b[0][ni], acc[mi][ni], 0, 0, 0);
        if (st + 1 < nsteps) {
            if (st + 2 < nsteps) {
#pragma unroll
                for (int i = 0; i < 4; ++i) { a[0][i] = *(const bf16x8*)(ap + (size_t)(16 * i) * lda + 32 * (st + 2)); b[0][i] = *(const bf16x8*)(bp + (size_t)(16 * i) * ldb + 32 * (st + 2)); } }
#pragma unroll
            for (int mi = 0; mi < 4; ++mi)
#pragma unroll
                for (int ni = 0; ni < 4; ++ni) acc[mi][ni] = __builtin_amdgcn_mfma_f32_16x16x32_bf16(a[1][mi], b[1][ni], acc[mi][ni], 0, 0, 0);
        }
    }
#pragma unroll
    for (int mi = 0; mi < 4; ++mi)
#pragma unroll
        for (int ni = 0; ni < 4; ++ni)
#pragma unroll
            for (int j = 0; j < 4; ++j) red[wid * 4096 + (16 * mi + 4 * fq + j) * 64 + 16 * ni + fr] = acc[mi][ni][j];
    __syncthreads();
    const int row = tid >> 3, cb = (tid & 7) * 8;
    float v[8];
    { float xf[8]; unpack8(*(const u32x4*)(XB + (size_t)(r0 + row) * 1024 + c0 + cb), xf);
#pragma unroll
      for (int q = 0; q < 8; ++q) v[q] = xf[q]; }
#pragma unroll
    for (int w = 0; w < 8; ++w) { const f32x4 p0 = *(LAS const f32x4*)(red + w * 4096 + row * 64 + cb), p1 = *(LAS const f32x4*)(red + w * 4096 + row * 64 + cb + 4);
        v[0] += p0[0]; v[1] += p0[1]; v[2] += p0[2]; v[3] += p0[3]; v[4] += p1[0]; v[5] += p1[1]; v[6] += p1[2]; v[7] += p1[3]; }
    float sq = 0.f;
#pragma unroll
    for (int q = 0; q < 8; ++q) sq += v[q] * v[q];
    *(u32x4*)(XB + (size_t)(r0 + row) * 1024 + c0 + cb) = pack8(v);
    sq += __shfl_xor(sq, 1); sq += __shfl_xor(sq, 2); sq += __shfl_xor(sq, 4);
    if ((tid & 7) == 0) ss[(size_t)(c0 >> 6) * MTOK + r0 + row] = sq;
    __syncthreads();
}

__device__ __forceinline__ void small_oddin_unit(const bf16_t* A, int lda, const bf16_t* Bt, int ldb, int K, int r0, int c0, const float* ss, bf16_t* U, bf16_t* V, float* lns, LAS unsigned char* lds) {
    const int tid = get_tid(), wid = tid >> 6, lane = tid & 63, fr = lane & 15, fq = lane >> 4;
    LAS float* red = (LAS float*)lds;
    const int kw = K >> 3, k0 = wid * kw, nsteps = kw >> 5;
    const bf16_t* ap = A + (size_t)(r0 + fr) * lda + k0 + 8 * fq;
    const bf16_t* bp = Bt + (size_t)(c0 + fr) * ldb + k0 + 8 * fq;
    f32x4 acc[4][4];
#pragma unroll
    for (int mi = 0; mi < 4; ++mi)
#pragma unroll
        for (int ni = 0; ni < 4; ++ni) acc[mi][ni] = (f32x4){0.f, 0.f, 0.f, 0.f};
    bf16x8 a[2][4], b[2][4];
#pragma unroll
    for (int i = 0; i < 4; ++i) { a[0][i] = *(const bf16x8*)(ap + (size_t)(16 * i) * lda); b[0][i] = *(const bf16x8*)(bp + (size_t)(16 * i) * ldb); }
#pragma unroll 1
    for (int st = 0; st < nsteps; st += 2) {
        if (st + 1 < nsteps) {
#pragma unroll
            for (int i = 0; i < 4; ++i) { a[1][i] = *(const bf16x8*)(ap + (size_t)(16 * i) * lda + 32 * (st + 1)); b[1][i] = *(const bf16x8*)(bp + (size_t)(16 * i) * ldb + 32 * (st + 1)); } }
#pragma unroll
        for (int mi = 0; mi < 4; ++mi)
#pragma unroll
            for (int ni = 0; ni < 4; ++ni) acc[mi][ni] = __builtin_amdgcn_mfma_f32_16x16x32_bf16(a[0][mi], b[0][ni], acc[mi][ni], 0, 0, 0);
        if (st + 1 < nsteps) {
            if (st + 2 < nsteps) {
#pragma unroll
                for (int i = 0; i < 4; ++i) { a[0][i] = *(const bf16x8*)(ap + (size_t)(16 * i) * lda + 32 * (st + 2)); b[0][i] = *(const bf16x8*)(bp + (size_t)(16 * i) * ldb + 32 * (st + 2)); } }
#pragma unroll
            for (int mi = 0; mi < 4; ++mi)
#pragma unroll
                for (int ni = 0; ni < 4; ++ni) acc[mi][ni] = __builtin_amdgcn_mfma_f32_16x16x32_bf16(a[1][mi], b[1][ni], acc[mi][ni], 0, 0, 0);
        }
    }
#pragma unroll
    for (int mi = 0; mi < 4; ++mi)
#pragma unroll
        for (int ni = 0; ni < 4; ++ni)
#pragma unroll
            for (int j = 0; j < 4; ++j) red[wid * 4096 + (16 * mi + 4 * fq + j) * 64 + 16 * ni + fr] = acc[mi][ni][j];
    __syncthreads();
    const int row = tid >> 3, cb = (tid & 7) * 8;
    float v[8];
#pragma unroll
    for (int q = 0; q < 8; ++q) v[q] = 0.f;
    float s2 = 0.f;
#pragma unroll
    for (int j = 0; j < 16; ++j) s2 += ss[(size_t)j * MTOK + r0 + row];
    const float rstd = rsqrtf(s2 * (1.f / 1024.f) + EPS);
#pragma unroll
    for (int w = 0; w < 8; ++w) { const f32x4 p0 = *(LAS const f32x4*)(red + w * 4096 + row * 64 + cb), p1 = *(LAS const f32x4*)(red + w * 4096 + row * 64 + cb + 4);
        v[0] += p0[0]; v[1] += p0[1]; v[2] += p0[2]; v[3] += p0[3]; v[4] += p1[0]; v[5] += p1[1]; v[6] += p1[2]; v[7] += p1[3]; }
    float sm = 0.f, sq = 0.f;
#pragma unroll
    for (int q = 0; q < 8; ++q) { v[q] = gelu_t(v[q] * rstd); sm += v[q]; sq += v[q] * v[q]; }
    const bool isv = c0 >= 1024;
    bf16_t* dst = isv ? V + (size_t)(r0 + row) * 1024 + (c0 - 1024) + cb : U + (size_t)(r0 + row) * 1024 + c0 + cb;
    *(u32x4*)dst = pack8(v);
    sm += __shfl_xor(sm, 1); sm += __shfl_xor(sm, 2); sm += __shfl_xor(sm, 4);
    sq += __shfl_xor(sq, 1); sq += __shfl_xor(sq, 2); sq += __shfl_xor(sq, 4);
    if (isv && (tid & 7) == 0) { const int slot = (c0 - 1024) >> 6; lns[(size_t)slot * MTOK + r0 + row] = sm; lns[(size_t)(16 + slot) * MTOK + r0 + row] = sq; }
    __syncthreads();
}

#define XB_TMO      128
#define XB_XCNT(j)  (256  + 64 * (j))
#define XB_XSUB(j)  (1280 + 64 * (j))
#define XB_XGEN(j)  (2304 + 64 * (j))
#define XB_TOP      3328
#define XB_TOPGEN   3392
#define XCD_BAR_WORDS 3456
#define XB_SPIN_CAP (1u << 18)
__device__ __forceinline__ unsigned xb_ld(unsigned* p)              { return __hip_atomic_load(p, __ATOMIC_RELAXED, __HIP_MEMORY_SCOPE_AGENT); }
__device__ __forceinline__ unsigned xb_add(unsigned* p, unsigned v) { return __hip_atomic_fetch_add(p, v, __ATOMIC_RELAXED, __HIP_MEMORY_SCOPE_AGENT); }
__device__ __forceinline__ unsigned xb_xcc_id() { return (unsigned)__builtin_amdgcn_s_getreg((3 << 11) | 20) & 0xFu; }
#define XB_SPIN(cond, bar) do { unsigned _sp = 0; while (cond) { __builtin_amdgcn_s_sleep(1); \
    if ((++_sp & 255u) == 0u) { if (xb_ld(&(bar)[XB_TMO])) break; if (_sp > XB_SPIN_CAP) { atomicAdd(&(bar)[XB_TMO], 1u); break; } } } } while (0)
struct XcdBarrier { unsigned* bar; unsigned x; volatile LAS unsigned* st; };
__device__ __forceinline__ XcdBarrier xcd_barrier_post(unsigned* bar, volatile LAS unsigned* st) {
    XcdBarrier b; b.bar = bar; b.x = xb_xcc_id(); b.st = st;
    if (threadIdx.x == 0) (void)xb_add(&bar[XB_XCNT(b.x)], 1u);
    return b;
}
__device__ __forceinline__ void xcd_barrier_complete(unsigned* bar, unsigned x, unsigned& nloc, unsigned& nx) {
    const unsigned G = gridDim.x * gridDim.y * gridDim.z;
    unsigned sum, cnt, mine, sp = 0u;
    for (;;) {
        sum = 0u; cnt = 0u; mine = 0u;
#pragma unroll
        for (unsigned j = 0; j < 16; ++j) { const unsigned c = xb_ld(&bar[XB_XCNT(j)]); sum += c; cnt += (c > 0u) ? 1u : 0u; mine = (j == x) ? c : mine; }
        if (sum == G) break;
        __builtin_amdgcn_s_sleep(1);
        if ((++sp & 255u) == 0u) { if (xb_ld(&bar[XB_TMO])) break; if (sp > XB_SPIN_CAP) { atomicAdd(&bar[XB_TMO], 1u); break; } }
    }
    nloc = mine > 0u ? mine : 1u; nx = cnt > 0u ? cnt : 1u;
}
__device__ __forceinline__ void xcd_barrier(const XcdBarrier& b) {
    asm volatile("s_waitcnt vmcnt(0)" ::: "memory");
    __syncthreads();
    if (threadIdx.x == 0) {
        unsigned* bar = b.bar;
        __builtin_amdgcn_s_waitcnt(0);
        unsigned nloc = b.st[0], nx = b.st[1];
        if (nloc == 0u) { xcd_barrier_complete(bar, b.x, nloc, nx); b.st[0] = nloc; b.st[1] = nx; }
        const unsigned old = xb_add(&bar[XB_XSUB(b.x)], 1u);
        const unsigned gen = old / nloc;
        if (old + 1u == (gen + 1u) * nloc) {
            __builtin_amdgcn_fence(__ATOMIC_RELEASE, "agent");
            asm volatile("s_waitcnt vmcnt(0)" ::: "memory");
            const unsigned og = xb_add(&bar[XB_TOP], 1u);
            const unsigned tg = og / nx;
            if (og + 1u == (tg + 1u) * nx) xb_add(&bar[XB_TOPGEN], 1u);
            else XB_SPIN(xb_ld(&bar[XB_TOPGEN]) == tg, bar);
            __builtin_amdgcn_fence(__ATOMIC_ACQUIRE, "agent");
            xb_add(&bar[XB_XGEN(b.x)], 1u);
            asm volatile("s_waitcnt vmcnt(0)" ::: "memory");
        } else {
            XB_SPIN(xb_ld(&bar[XB_XGEN(b.x)]) == gen, bar);
            __builtin_amdgcn_fence(__ATOMIC_ACQUIRE, "agent");
            asm volatile("s_waitcnt vmcnt(0)" ::: "memory");
        }
    }
    __syncthreads();
}

__global__ void __launch_bounds__(512) mega(const Params Pkarg, const int ph_lo, const int ph_hi) {
    extern __shared__ __attribute__((aligned(16))) unsigned char shm[];
    LAS unsigned char* lds = (LAS unsigned char*)shm;
    LAS float* rsbuf = (LAS float*)(lds + pg8::STAGE_BYTES);
    volatile LAS unsigned* xbst = (volatile LAS unsigned*)(lds + LDS_BYTES - 16);
    XcdBarrier xb; xb.bar = nullptr; xb.x = 0; xb.st = xbst;
    if (ph_hi - ph_lo > 1) {
        if (threadIdx.x == 0) { xbst[0] = 0u; xbst[1] = 0u; }
        __syncthreads();
        xb = xcd_barrier_post((unsigned*)(((CParams*)__builtin_amdgcn_kernarg_segment_ptr())->ws + WS_BAR), xbst);
    }
    for (int ph = ph_lo; ph < ph_hi; ++ph) {
        const int G = get_gdim(), bid = get_bid();
        CParams* Pp = (CParams*)__builtin_amdgcn_kernarg_segment_ptr();
        asm volatile("" : "+s"(Pp));
        CParams& P = *Pp;
        unsigned char* big = P.ws + WS_BIG;
        int kind, l = 0;
        if (ph == 0) kind = 0;
        else if (ph == NPHASE - 1) kind = 12;
        else { int q = ph - 1; if (q < 8) l = 0; else if (q < 14) { l = 1; q -= 8; } else if (q < 22) { l = 2; q -= 14; } else { l = 3; q -= 22; }
            const int nm = (l & 1) ? 3 : 5; kind = q < nm ? ((l & 1) ? 6 + q : 1 + q) : 9 + (q - nm); }
        const int e = l >> 1;
#ifdef DUP_KIND
        const int reps = (kind == DUP_KIND) ? 3 : 1;
#else
        const int reps = 1;
#endif
        for (int rep = 0; rep < reps; ++rep)
        switch (kind) {
#ifndef PMASK
#define PMASK 0xFFFF
#endif
#define PM(k) if (PMASK & (1 << (k)))
        case 0: PM(0) phase_prep(P, lds); break;
        case 1: PM(1) {
            pg8::Gemm g{(const bf16_t*)(P.ws + WS_XB), (const bf16_t*)(P.ws + WS_EIN) + (size_t)e * 2560 * 1024, MTOK, 2560, 1024, 1024, 1024};
            pg8::StaticOrder S; S.init(MTOK, 2560, G, bid); pg8::precompute_rstd(S, (const float*)(P.ws + WS_SS), rsbuf);
            pg8::EpiScaleBf16 E{(bf16_t*)(big + B_ZB), NZ, rsbuf};
            pg8::gemm_phase(lds, g, S, E);
            phase_gates(P, e, lds);
        } break;
        case 2: PM(2) {
            for (int u = bid; u < 512; u += G) e2_unit(P, u, lds);
            for (int u = bid; u < 528; u += G) pool_unit(P, e, u >> 2, u & 3, lds);
        } break;
        case 3: PM(3) {
            phase_scan(P, e);
            for (int u = bid; u < 512; u += G) mlstm_sample_unit(P, e, u, lds);
        } break;
        case 4: PM(4) for (int u = bid; u < 512; u += G) e4_unit(P, e, u, lds); break;
        case 5: case 8: case 11: PM(5) {
            pg8::Gemm g;
            if (kind == 5) g = pg8::Gemm{(const bf16_t*)(big + B_YMIX), (const bf16_t*)(P.ws + WS_EOUT) + (size_t)e * 1024 * 1024, MTOK, 1024, 1024, 1024, 1024};
            else if (kind == 8) g = pg8::Gemm{(const bf16_t*)(big + B_US), (const bf16_t*)(P.ws + WS_OOUT) + (size_t)e * 1024 * 1024, MTOK, 1024, 1024, 1024, 1024};
            else g = pg8::Gemm{(const bf16_t*)(big + B_G), (const bf16_t*)(P.ws + WS_F2) + (size_t)l * 1024 * 2816, MTOK, 1024, FF, FF, FF};
            pg8::StaticOrder S; S.init(MP, 1024, G, bid);
            pg8::EpiResid E{(bf16_t*)(P.ws + WS_XB), (float*)(P.ws + WS_SS)};
            pg8::gemm_phase(lds, g, S, E);
            for (int u = bid; u < 128; u += G)
                small_resid_unit(g.A, g.lda, g.Bt, g.ldb, g.K, MP + (u >> 4) * 64, (u & 15) * 64, (bf16_t*)(P.ws + WS_XB), (float*)(P.ws + WS_SS), lds);
        } break;
        case 6: PM(6) {
            pg8::Gemm g{(const bf16_t*)(P.ws + WS_XB), (const bf16_t*)(P.ws + WS_OIN) + (size_t)e * 2048 * 1024, MTOK, 2048, 1024, 1024, 1024};
            pg8::StaticOrder S; S.init(MP, 2048, G, bid); pg8::precompute_rstd(S, (const float*)(P.ws + WS_SS), rsbuf);
            pg8::EpiOddIn E{(bf16_t*)(big + B_U), (bf16_t*)(big + B_VPRE), (float*)(big + B_LNS), rsbuf};
            pg8::gemm_phase(lds, g, S, E);
            for (int u = bid; u < 256; u += G)
                small_oddin_unit(g.A, g.lda, g.Bt, g.ldb, g.K, MP + (u >> 5) * 64, (u & 31) * 64, (const float*)(P.ws + WS_SS), (bf16_t*)(big + B_U), (bf16_t*)(big + B_VPRE), (float*)(big + B_LNS), lds);
        } break;
        case 7: PM(7) {
            for (int u = bid; u < 512; u += G) sgu_unit(P, e, u, lds);
            sgu_sample(P, e);
        } break;
        case 9: PM(9) {
            pg8::Gemm g{(const bf16_t*)(P.ws + WS_XB), (const bf16_t*)(P.ws + WS_F1) + (size_t)l * 5632 * 1024, MTOK, 5632, 1024, 1024, 1024};
            pg8::StaticOrder S; S.init(MTOK, 5632, G, bid); pg8::precompute_rstd(S, (const float*)(P.ws + WS_SS), rsbuf);
            pg8::EpiFfn E{(bf16_t*)(big + B_G), (bf16_t*)(big + B_AUS), (float*)(big + B_HF), (float*)(big + B_HU), (float*)(big + B_HL), rsbuf, P.in[23] + (size_t)l * 3 * FF, P.in[24] + (size_t)l * FF};
            pg8::gemm_phase(lds, g, S, E);
        } break;
        case 10: PM(10) phase_conv(P, l, lds); break;
        case 12: PM(12) phase_final(P); break;
        }
#if USE_CG_SYNC
        if (ph + 1 < ph_hi) cg::this_grid().sync();
#else
        if (ph + 1 < ph_hi) { if (ph_lo < 0) cg::this_grid().sync(); else xcd_barrier(xb); }
#endif
    }
}

static void add_job(Params& p, int& nj, int& items, const float* W, bf16_t* WT, const float* gk, int K, int ldw, int ncols, int ldt, int n_lo, int n_hi, float nscale) {
    TJob& j = p.jobs[nj++]; j.W = W; j.WT = WT; j.gk = gk; j.K = K; j.ldw = ldw; j.ncols = ncols; j.ldt = ldt; j.n_lo = n_lo; j.n_hi = n_hi; j.nscale = nscale; j.item0 = items; j.rmode = 0; j.roff = 0;
    items += (K / 64) * (ncols / 32);
}

extern "C" void kernel_launch(void* const* d_in, const int* in_sizes, int n_in, void* d_out, int out_size, void* d_ws, size_t ws_size, hipStream_t stream) {
    static int grid = 0;
    if (grid == 0) {
        if (n_in != 27 || ws_size < WS_END) { fprintf(stderr, "kernel_launch: need 27 inputs and %zu bytes of workspace (got %d, %zu)\n", (size_t)WS_END, n_in, ws_size); grid = -1; return; }
        int dev = 0, cus = 0, per_cu = 0;
        (void)hipGetDevice(&dev); (void)hipDeviceGetAttribute(&cus, hipDeviceAttributeMultiprocessorCount, dev);
        if (hipFuncSetAttribute((const void*)mega, hipFuncAttributeMaxDynamicSharedMemorySize, LDS_BYTES) != hipSuccess) { fprintf(stderr, "hipFuncSetAttribute failed\n"); grid = -1; return; }
        (void)hipOccupancyMaxActiveBlocksPerMultiprocessor(&per_cu, (const void*)mega, 512, LDS_BYTES);
        if (per_cu < 1) per_cu = 1;
        (void)hipGetLastError();
        grid = cus * 1;
    }
    if (grid < 0) return;
    Params p; memset(&p, 0, sizeof(p));
    for (int i = 0; i < 27; ++i) p.in[i] = (const float*)d_in[i];
    p.out = (float*)d_out; p.ws = (unsigned char*)d_ws;
    unsigned char* ws = (unsigned char*)d_ws;
    int nj = 0, items = 0;
    const float kq = 0.08838834764831845f;
    for (int e = 0; e < 2; ++e) add_job(p, nj, items, p.in[8] + (size_t)e * 1024 * 2568, (bf16_t*)(ws + WS_EIN) + (size_t)e * 2560 * 1024, p.in[7] + (2 * e) * 1024, 1024, 2568, 2560, 1024, 1024, 1536, kq);
    for (int e = 0; e < 2; ++e) add_job(p, nj, items, p.in[13] + (size_t)e * 1024 * 1024, (bf16_t*)(ws + WS_EOUT) + (size_t)e * 1024 * 1024, nullptr, 1024, 1024, 1024, 1024, 0, 0, 1.f);
    for (int o = 0; o < 2; ++o) add_job(p, nj, items, p.in[14] + (size_t)o * 1024 * 2048, (bf16_t*)(ws + WS_OIN) + (size_t)o * 2048 * 1024, p.in[7] + (2 * o + 1) * 1024, 1024, 2048, 2048, 1024, 0, 0, 1.f);
    for (int o = 0; o < 2; ++o) add_job(p, nj, items, p.in[19] + (size_t)o * 1024 * 1024, (bf16_t*)(ws + WS_OOUT) + (size_t)o * 1024 * 1024, nullptr, 1024, 1024, 1024, 1024, 0, 0, 1.f);
    for (int l = 0; l < 4; ++l) {
        add_job(p, nj, items, p.in[21] + (size_t)l * 1024 * FF, (bf16_t*)(ws + WS_F1) + (size_t)l * 5632 * 1024, p.in[20] + l * 1024, 1024, FF, FF, 1024, 0, 0, 1.f);
        p.jobs[nj - 1].rmode = 1; p.jobs[nj - 1].roff = 0;
        add_job(p, nj, items, p.in[22] + (size_t)l * 1024 * FF, (bf16_t*)(ws + WS_F1) + (size_t)l * 5632 * 1024, p.in[20] + l * 1024, 1024, FF, FF, 1024, 0, 0, 1.f);
        p.jobs[nj - 1].rmode = 1; p.jobs[nj - 1].roff = 128;
    }
    for (int l = 0; l < 4; ++l) add_job(p, nj, items, p.in[25] + (size_t)l * FF * 1024, (bf16_t*)(ws + WS_F2) + (size_t)l * 1024 * FF, nullptr, FF, 1024, 1024, FF, 0, 0, 1.f);
    p.nitems = items;
#ifndef RUN_HI
#define RUN_HI NPHASE
#endif
#if ONE_LAUNCH
    (void)hipMemsetAsync((unsigned char*)d_ws + WS_BAR, 0, 16384, stream);
    int lo = 0, hi = RUN_HI;
    void* args[] = {(void*)&p, (void*)&lo, (void*)&hi};
    hipError_t err = hipLaunchCooperativeKernel((const void*)mega, dim3(grid), dim3(512), args, LDS_BYTES, stream);
    if (err != hipSuccess) fprintf(stderr, "cooperative launch failed: %s (grid %d)\n", hipGetErrorString(err), grid);
#else
    for (int ph = 0; ph < RUN_HI; ++ph) hipLaunchKernelGGL(mega, dim3(grid), dim3(512), LDS_BYTES, stream, p, ph, ph + 1);
#endif
}
```

```cpp
#include <hip/hip_runtime.h>
#include <hip/hip_cooperative_groups.h>
#include <cstdio>
#include <cstring>
namespace cg = cooperative_groups;

#define LAS __attribute__((address_space(3)))
typedef unsigned short bf16_t;
typedef short bf16x8 __attribute__((ext_vector_type(8)));
typedef float f32x4 __attribute__((ext_vector_type(4)));
typedef unsigned u32x4 __attribute__((ext_vector_type(4)));
typedef unsigned u32x2 __attribute__((ext_vector_type(2)));

#ifndef USE_CG_SYNC
#define USE_CG_SYNC 0
#endif
#ifndef ONE_LAUNCH
#define ONE_LAUNCH 1

#endif

constexpr int MTOK = 16896, MP = 16384, DM = 1024, NZ = 2560, FF = 2816, AUW = 5632;
constexpr float EPS = 1e-6f;
constexpr int NPHASE = 30;
constexpr int LDS_BYTES = 147456;

constexpr size_t O_POOLP = 17301504, O_POOLS = 17424384, O_CP = 19390464, O_CS = 20439040, O_NP = 37216256, O_NS = 37224448,
                 O_MP = 37355520, O_MS = 37355584, O_CONVP = 37356608, O_CONVS = 37536832, O_V = 40420416;

constexpr size_t WS_EIN = 0;
constexpr size_t WS_EOUT = WS_EIN + 2ull * 2560 * 1024 * 2;
constexpr size_t WS_OIN = WS_EOUT + 2ull * 1024 * 1024 * 2;
constexpr size_t WS_OOUT = WS_OIN + 2ull * 2048 * 1024 * 2;
constexpr size_t WS_F1 = WS_OOUT + 2ull * 1024 * 1024 * 2;
constexpr size_t WS_F2 = WS_F1 + 4ull * 5632 * 1024 * 2;
constexpr size_t WS_WG = WS_F2 + 4ull * 1024 * 2816 * 2;
constexpr size_t WS_WPOOL = WS_WG + 2ull * 8 * 1024 * 4;
constexpr size_t WS_WSP = WS_WPOOL + 2ull * 4 * 128 * 128 * 2;
constexpr size_t WS_XB = WS_WSP + 2ull * 4 * 128 * 128 * 2;
constexpr size_t WS_SS = WS_XB + (size_t)MTOK * 1024 * 2;
constexpr size_t WS_BIG = WS_SS + 16ull * MTOK * 4;
constexpr size_t WS_BAR = WS_BIG + (size_t)MTOK * AUW * 2;
constexpr size_t WS_WGB = WS_BAR + 16384;
constexpr size_t WS_END = WS_WGB + 2ull * 16 * 1024 * 2;
constexpr size_t B_ZB = 0;
constexpr size_t B_GATES = B_ZB + (size_t)MTOK * NZ * 2;
constexpr size_t B_BT = B_GATES + (size_t)MTOK * 8 * 4;
constexpr size_t B_SCAL = B_BT + (size_t)MP * 4 * 4;
constexpr size_t B_DC = B_SCAL + 512 * 4 * 4;
constexpr size_t B_DN = B_DC + 512ull * 16384 * 4;
constexpr size_t B_CPREV = B_DN + 512ull * 128 * 4;
constexpr size_t B_NPREV = B_CPREV + 512ull * 16384 * 2;
constexpr size_t B_YMIX = B_NPREV + 512ull * 128 * 4;
constexpr size_t B_EVEN_END = B_YMIX + (size_t)MTOK * 1024 * 2;
static_assert(B_EVEN_END <= (size_t)MTOK * AUW * 2, "even scratch too big");
constexpr size_t B_G = 0;
constexpr size_t B_AUS = B_G + (size_t)MTOK * FF * 2;
constexpr size_t B_HF = B_AUS + 512ull * AUW * 2;
constexpr size_t B_HU = B_HF + 256ull * 2 * FF * 4;
constexpr size_t B_HL = B_HU + 256ull * 2 * FF * 4;
constexpr size_t B_U = 0;
constexpr size_t B_VPRE = B_U + (size_t)MTOK * 1024 * 2;
constexpr size_t B_LNS = B_VPRE + (size_t)MTOK * 1024 * 2;
constexpr size_t B_US = B_LNS + 2ull * 16 * MTOK * 4;

struct TJob { const float* W; bf16_t* WT; const float* gk; int K, ldw, ncols, ldt, n_lo, n_hi; float nscale; int item0; int rmode, roff; };
constexpr int NJOBS = 20;
struct Params {
    const float* in[27];
    float* out;
    unsigned char* ws;
    TJob jobs[NJOBS];
    int nitems; int pad;
};

typedef const __attribute__((address_space(4))) Params CParams;
typedef const __attribute__((address_space(4))) TJob CTJob;

__device__ __forceinline__ unsigned cvt_pk_bf16(float lo, float hi) { unsigned r; asm volatile("v_cvt_pk_bf16_f32 %0, %1, %2" : "=v"(r) : "v"(lo), "v"(hi)); return r; }
__device__ __forceinline__ bf16_t f2bf(float f) { return (bf16_t)(cvt_pk_bf16(f, 0.f) & 0xffffu); }
__device__ __forceinline__ float bf2f(bf16_t b) { return __uint_as_float(((unsigned)b) << 16); }
__device__ __forceinline__ float bflo(unsigned u) { return __uint_as_float(u << 16); }
__device__ __forceinline__ float bfhi(unsigned u) { return __uint_as_float(u & 0xffff0000u); }
__device__ __forceinline__ float wave_sum(float v) {
#pragma unroll
    for (int o = 1; o < 64; o <<= 1) v += __shfl_xor(v, o);
    return v;
}
__device__ __forceinline__ float wave_max(float v) {
#pragma unroll
    for (int o = 1; o < 64; o <<= 1) v = fmaxf(v, __shfl_xor(v, o));
    return v;
}
__device__ __forceinline__ float gelu_t(float x) {
    const float x2 = x * x;
    const float t = x * __builtin_fmaf(x2, -0.10294324f, -2.3022082f);
    return x * __builtin_amdgcn_rcpf(1.f + __builtin_amdgcn_exp2f(t));
}
typedef float f32x2 __attribute__((ext_vector_type(2)));
__device__ __forceinline__ f32x2 gelu_t2(f32x2 v) {
    const f32x2 x2 = v * v;
    const f32x2 t = v * (x2 * (-0.10294324f) + (-2.3022082f));
    f32x2 e; e.x = __builtin_amdgcn_exp2f(t.x); e.y = __builtin_amdgcn_exp2f(t.y);
    const f32x2 d = e + 1.0f;
    f32x2 r; r.x = __builtin_amdgcn_rcpf(d.x); r.y = __builtin_amdgcn_rcpf(d.y);
    return v * r;
}
__device__ __forceinline__ float sigmoidf_(float x) { return __builtin_amdgcn_rcpf(1.f + __expf(-x)); }
__device__ __forceinline__ void unpack8(const u32x4 v, float (&f)[8]) {
    f[0] = bflo(v.x); f[1] = bfhi(v.x); f[2] = bflo(v.y); f[3] = bfhi(v.y); f[4] = bflo(v.z); f[5] = bfhi(v.z); f[6] = bflo(v.w); f[7] = bfhi(v.w);
}
__device__ __forceinline__ u32x4 pack8(const float (&f)[8]) {
    u32x4 o; o.x = cvt_pk_bf16(f[0], f[1]); o.y = cvt_pk_bf16(f[2], f[3]); o.z = cvt_pk_bf16(f[4], f[5]); o.w = cvt_pk_bf16(f[6], f[7]); return o;
}
__device__ __forceinline__ int get_tid() { int t = threadIdx.x; asm volatile("" : "+v"(t)); return t; }
__device__ __forceinline__ int get_bid() { int t = blockIdx.x; asm volatile("" : "+s"(t)); return t; }
__device__ __forceinline__ int get_gdim() { int t = gridDim.x; asm volatile("" : "+s"(t)); return t; }
#define LDS_WAIT() asm volatile("s_waitcnt lgkmcnt(0)" ::: "memory")

namespace pg8 {
constexpr int BM = 256, BK = 64, HALF = 128, HTB = HALF * BK * 2, STAGE_BYTES = 8 * HTB, NXCD = 8, WGM = 8;
__device__ __forceinline__ int lds_byte(int r, int c) { const int st = (r >> 4) * 2 + (c >> 5), rr = r & 15, cc = c & 31, ob = rr * 64 + cc * 2; return st * 1024 + (ob ^ (((ob >> 9) & 1) << 5)); }
__device__ __forceinline__ void stage_rc(int b, int& R, int& C) { const int st = b / 1024, sb = b % 1024, swz = sb ^ (((sb >> 9) & 1) << 5); R = (st >> 1) * 16 + swz / 64; C = (st & 1) * 32 + (swz % 64) / 2; }
__device__ __forceinline__ int perm32(int rho) { const int n = rho >> 4, i = rho & 15; return 8 * (i >> 2) + 4 * n + (i & 3); }
struct Unit { int pm, pn; };
struct Gemm { const bf16_t* A; const bf16_t* Bt; int M, N, K, lda, ldb; };
struct StaticOrder {
    int nM, nN, nwg, G, c;
    __device__ void init(int M, int N, int G_, int c_) { nM = M / BM; nN = N / BM; nwg = nM * nN; G = G_; c = c_; }
    __device__ bool next(int i, Unit& u) const {
        const long L = (long)i * G + c; if (L >= nwg) return false;
        int wgid = (int)L; { const int q = nwg / NXCD, r = nwg % NXCD, xcd = wgid % NXCD, off = wgid / NXCD; wgid = (xcd < r ? xcd * (q + 1) : r * (q + 1) + (xcd - r) * q) + off; }
        const int nig = WGM * nN, gid = wgid / nig, fm = gid * WGM, gsz = (nM - fm) < WGM ? (nM - fm) : WGM;
        u.pm = fm + ((wgid % nig) % gsz); u.pn = (wgid % nig) / gsz; return true;
    }
    __device__ __forceinline__ void a_ready(const Unit&, int) const {}
};
__device__ __forceinline__ void precompute_rstd(const StaticOrder& S, const float* ss, LAS float* rs) {
    const int tid = get_tid(), half = tid >> 8, row = tid & 255;
    float sum[3]; bool ok[3];
#pragma unroll
    for (int k = 0; k < 3; ++k) { Unit u; ok[k] = S.next(half + 2 * k, u); sum[k] = 0.f;
        if (ok[k]) { const int r = u.pm * BM + row;
#pragma unroll
            for (int j = 0; j < 16; ++j) sum[k] += ss[(size_t)j * MTOK + r]; } }
#pragma unroll
    for (int k = 0; k < 3; ++k) if (ok[k]) rs[(half + 2 * k) * 256 + row] = rsqrtf(sum[k] * (1.f / 1024.f) + EPS);
    __syncthreads();
}

template <class Epi, class Sched>
__device__ __forceinline__ void gemm_phase(LAS unsigned char* lds, const Gemm g, const Sched& S, const Epi& E) {
    const int tid = get_tid(), wid = __builtin_amdgcn_readfirstlane(tid >> 6), lane = tid & 63, wr = wid >> 2, wc = wid & 3, fr = lane & 15, fq = lane >> 4;
    const int K = g.K, nt = K / BK;
    unsigned voffA, voffB;
    { int R, C; stage_rc(tid * 16, R, C);
      const int Rb = (R & ~31) + perm32(R & 31);
      voffA = (unsigned)(R * g.lda + C) * 2u; voffB = (unsigned)(Rb * g.ldb + C) * 2u; }
    const size_t dstepA = (size_t)64 * g.lda * 2, dstepB = (size_t)64 * g.ldb * 2;
    const size_t kstep = (size_t)(BK * 2);
    const size_t hstepA = (size_t)HALF * g.lda * 2, hstepB = (size_t)HALF * g.ldb * 2;
    const size_t tstepA = 2 * hstepA, tstepB = 2 * hstepB;
    const unsigned ldsw = (unsigned)wid * 1024u;
    const int aoff = lds_byte(wr * 64 + fr, fq * 8), boff = lds_byte(wc * 32 + fr, fq * 8);
#define PG8_SA(b, h) (((b) * 2 + (h)) * HTB)
#define PG8_SB(b, h) ((4 + (b) * 2 + (h)) * HTB)
#define PG8_STAGE(bufoff, gbase, voff) do { _Pragma("unroll") for (int _i = 0; _i < 2; ++_i) \
        __builtin_amdgcn_global_load_lds((const unsigned*)((const char*)(gbase) + (size_t)_i * d##voff + (voff)), (LAS unsigned*)(lds + (bufoff) + ldsw + _i * 8192), 16, 0, 0); } while (0)
#define dvoffA dstepA
#define dvoffB dstepB
#define PG8_LDA(dst, b, h) do { _Pragma("unroll") for (int m = 0; m < 4; ++m) _Pragma("unroll") for (int k = 0; k < 2; ++k) dst[m][k] = *(const LAS bf16x8*)(lds + PG8_SA(b, h) + aoff + m * 2048 + k * 1024); } while (0)
#define PG8_LDB(dst, b, h) do { _Pragma("unroll") for (int n = 0; n < 2; ++n) _Pragma("unroll") for (int k = 0; k < 2; ++k) dst[n][k] = *(const LAS bf16x8*)(lds + PG8_SB(b, h) + boff + n * 2048 + k * 1024); } while (0)
#define PG8_MMA(ai, bj, At, Bt) do { __builtin_amdgcn_s_setprio(1); _Pragma("unroll") for (int m = 0; m < 4; ++m) _Pragma("unroll") for (int n = 0; n < 2; ++n) _Pragma("unroll") for (int k = 0; k < 2; ++k) \
        acc[ai][bj][m][n] = __builtin_amdgcn_mfma_f32_16x16x32_bf16(Bt[n][k], At[m][k], acc[ai][bj][m][n], 0, 0, 0); __builtin_amdgcn_s_setprio(0); } while (0)
#define PG8_WAIT_V(n) asm volatile("s_waitcnt vmcnt(" #n ")" ::: "memory")
#define PG8_WAIT_L(n) asm volatile("s_waitcnt lgkmcnt(" #n ")" ::: "memory")
#define PG8_BAR __builtin_amdgcn_s_barrier()
#define PG8_SCHED __builtin_amdgcn_sched_barrier(0)
    Unit cur, nxt; int ui = 0;
    if (!S.next(0, cur)) return;
    f32x4 acc[2][2][4][2];
#pragma unroll
    for (int a = 0; a < 2; ++a)
#pragma unroll
        for (int b = 0; b < 2; ++b)
#pragma unroll
            for (int m = 0; m < 4; ++m)
#pragma unroll
                for (int n = 0; n < 2; ++n) acc[a][b][m][n] = (f32x4){0.f, 0.f, 0.f, 0.f};
    bf16x8 At[4][2], B0[2][2], B1[2][2];
    const char* cA = (const char*)g.A + (size_t)cur.pm * tstepA; const char* cB = (const char*)g.Bt + (size_t)cur.pn * tstepB;
    S.a_ready(cur, 0);
    PG8_STAGE(PG8_SB(0, 0), cB, voffB); PG8_STAGE(PG8_SA(0, 0), cA, voffA); PG8_STAGE(PG8_SB(0, 1), cB + hstepB, voffB); PG8_STAGE(PG8_SA(0, 1), cA + hstepA, voffA);
    if (wr == 1) PG8_BAR;
    PG8_WAIT_V(4); PG8_BAR;
    PG8_STAGE(PG8_SB(1, 0), cB + kstep, voffB); PG8_STAGE(PG8_SA(1, 0), cA + kstep, voffA); PG8_STAGE(PG8_SB(1, 1), cB + hstepB + kstep, voffB);
    PG8_WAIT_V(6); PG8_BAR;
    for (;;) {
        const bool has_next = S.next(ui + 1, nxt);
        const char* nA = has_next ? (const char*)g.A + (size_t)nxt.pm * tstepA : cA; const char* nB = has_next ? (const char*)g.Bt + (size_t)nxt.pn * tstepB : cB;
        for (int t = 0; t < nt; t += 2) {
            const bool last = (t == nt - 2);
            const char* a1 = cA + (size_t)(t + 1) * kstep;
            const char* a2 = last ? nA : cA + (size_t)(t + 2) * kstep; const char* b2 = last ? nB : cB + (size_t)(t + 2) * kstep;
            const char* a3 = a2 + kstep; const char* b3 = b2 + kstep;
            if (last && has_next) S.a_ready(nxt, ui + 1);
            PG8_LDB(B0, 0, 0); PG8_SCHED; PG8_LDA(At, 0, 0); PG8_STAGE(PG8_SA(1, 1), a1 + hstepA, voffA);
            PG8_WAIT_L(8); PG8_BAR; PG8_WAIT_L(0); PG8_MMA(0, 0, At, B0); PG8_BAR; PG8_SCHED;
            PG8_LDB(B1, 0, 1); PG8_STAGE(PG8_SB(0, 0), b2, voffB);
            PG8_BAR; PG8_WAIT_L(0); PG8_MMA(0, 1, At, B1); PG8_BAR;
            PG8_LDA(At, 0, 1); PG8_STAGE(PG8_SA(0, 0), a2, voffA);
            PG8_BAR; PG8_WAIT_L(0); PG8_MMA(1, 0, At, B0); PG8_BAR; PG8_SCHED;
            PG8_STAGE(PG8_SB(0, 1), b2 + hstepB, voffB);
            PG8_WAIT_V(6); PG8_BAR; PG8_MMA(1, 1, At, B1); PG8_BAR;
            PG8_LDB(B0, 1, 0); PG8_SCHED; PG8_LDA(At, 1, 0); PG8_STAGE(PG8_SA(0, 1), a2 + hstepA, voffA);
            PG8_WAIT_L(8); PG8_BAR; PG8_WAIT_L(0); PG8_MMA(0, 0, At, B0); PG8_BAR; PG8_SCHED;
            PG8_LDB(B1, 1, 1); PG8_STAGE(PG8_SB(1, 0), b3, voffB);
            PG8_BAR; PG8_WAIT_L(0); PG8_MMA(0, 1, At, B1); PG8_BAR;
            PG8_LDA(At, 1, 1); PG8_STAGE(PG8_SA(1, 0), a3, voffA);
            PG8_BAR; PG8_WAIT_L(0); PG8_MMA(1, 0, At, B0); PG8_BAR; PG8_SCHED;
            PG8_STAGE(PG8_SB(1, 1), b3 + hstepB, voffB);
            PG8_WAIT_V(6); PG8_BAR; PG8_MMA(1, 1, At, B1); PG8_BAR;
        }
        E(acc, cur, ui, wr, wc, fr, fq);
        if (!has_next) break;
#pragma unroll
        for (int a = 0; a < 2; ++a)
#pragma unroll
            for (int b = 0; b < 2; ++b)
#pragma unroll
                for (int m = 0; m < 4; ++m)
#pragma unroll
                    for (int n = 0; n < 2; ++n) acc[a][b][m][n] = (f32x4){0.f, 0.f, 0.f, 0.f};
        cur = nxt; cA = nA; cB = nB; ++ui;
    }
    PG8_WAIT_V(0);
    if (wr == 0) PG8_BAR;
    PG8_BAR;
#undef PG8_SA
#undef PG8_SB
#undef PG8_STAGE
#undef dvoffA
#undef dvoffB
#undef PG8_LDA
#undef PG8_LDB
#undef PG8_MMA
#undef PG8_WAIT_V
#undef PG8_WAIT_L
#undef PG8_BAR
#undef PG8_SCHED
}

struct EpiScaleBf16 {
    bf16_t* O; int ldc; LAS const float* rs;
    __device__ __forceinline__ void operator()(const f32x4 (&acc)[2][2][4][2], const Unit& u, int ui, int wr, int wc, int fr, int fq) const {
        LAS const float* r = rs + ui * 256;
#pragma unroll
        for (int ai = 0; ai < 2; ++ai)
#pragma unroll
            for (int m = 0; m < 4; ++m) {
                const int rl = ai * HALF + wr * 64 + m * 16 + fr; const float s = r[rl];
                bf16_t* rowp = O + (size_t)(u.pm * BM + rl) * ldc + u.pn * BM + wc * 32 + 8 * fq;
#pragma unroll
                for (int bj = 0; bj < 2; ++bj) { const f32x4 v0 = acc[ai][bj][m][0] * s, v1 = acc[ai][bj][m][1] * s;
                    u32x4 o; o.x = cvt_pk_bf16(v0[0], v0[1]); o.y = cvt_pk_bf16(v0[2], v0[3]); o.z = cvt_pk_bf16(v1[0], v1[1]); o.w = cvt_pk_bf16(v1[2], v1[3]);
                    *(u32x4*)(rowp + bj * HALF) = o; }
            }
    }
};
struct EpiOddIn {
    bf16_t* U; bf16_t* V; float* lns; LAS const float* rs;
    __device__ __forceinline__ void operator()(const f32x4 (&acc)[2][2][4][2], const Unit& u, int ui, int wr, int wc, int fr, int fq) const {
        LAS const float* r = rs + ui * 256;
        const bool isv = u.pn >= 4; bf16_t* O = isv ? V : U; const int pnl = isv ? u.pn - 4 : u.pn;
#pragma unroll
        for (int ai = 0; ai < 2; ++ai)
#pragma unroll
            for (int m = 0; m < 4; ++m) {
                const int rl = ai * HALF + wr * 64 + m * 16 + fr; const float s = r[rl]; const int row = u.pm * BM + rl;
                bf16_t* rowp = O + (size_t)row * 1024 + pnl * BM + wc * 32 + 8 * fq;
                float sm = 0.f, sq = 0.f;
#pragma unroll
                for (int bj = 0; bj < 2; ++bj) { unsigned pk[4];
#pragma unroll
                    for (int n = 0; n < 2; ++n) { f32x4 v = acc[ai][bj][m][n] * s;
                        { const f32x2 g0 = gelu_t2((f32x2){v[0], v[1]}), g1 = gelu_t2((f32x2){v[2], v[3]}); v[0] = g0.x; v[1] = g0.y; v[2] = g1.x; v[3] = g1.y; }
#pragma unroll
                        for (int j = 0; j < 4; ++j) { sm += v[j]; sq += v[j] * v[j]; }
                        pk[2 * n] = cvt_pk_bf16(v[0], v[1]); pk[2 * n + 1] = cvt_pk_bf16(v[2], v[3]); }
                    *(u32x4*)(rowp + bj * HALF) = (u32x4){pk[0], pk[1], pk[2], pk[3]}; }
                if (isv) {
                    sm += __shfl_xor(sm, 16); sm += __shfl_xor(sm, 32); sq += __shfl_xor(sq, 16); sq += __shfl_xor(sq, 32);
                    if (fq == 0) { const int slot = pnl * 4 + wc; lns[(size_t)slot * MTOK + row] = sm; lns[(size_t)(16 + slot) * MTOK + row] = sq; }
                }
            }
    }
};
__device__ __forceinline__ float dpp_ror1(float x) { return __int_as_float(__builtin_amdgcn_update_dpp(0, __float_as_int(x), 0x121, 0xf, 0xf, false)); }
__device__ __forceinline__ float dpp_ror2(float x) { return __int_as_float(__builtin_amdgcn_update_dpp(0, __float_as_int(x), 0x122, 0xf, 0xf, false)); }
__device__ __forceinline__ float dpp_shr1(float oldv, float x) { return __int_as_float(__builtin_amdgcn_update_dpp(__float_as_int(oldv), __float_as_int(x), 0x111, 0xf, 0xf, false)); }
__device__ __forceinline__ float dpp_shr2(float oldv, float x) { return __int_as_float(__builtin_amdgcn_update_dpp(__float_as_int(oldv), __float_as_int(x), 0x112, 0xf, 0xf, false)); }
struct EpiFfn {
    bf16_t* Gb; bf16_t* AUS; float* HF; float* HU; float* HL; LAS const float* rs; const float* cw; const float* cb;
    __device__ __forceinline__ void operator()(const f32x4 (&acc)[2][2][4][2], const Unit& u, int ui, int wr, int wc, int fr, int fq) const {
        LAS const float* r = rs + ui * 256;
        const int c0 = u.pn * 128 + wc * 32 + 8 * fq;
        if (u.pm >= 64) {
#pragma unroll
            for (int ai = 0; ai < 2; ++ai)
#pragma unroll
                for (int m = 0; m < 4; ++m) { const int rl = ai * HALF + wr * 64 + m * 16 + fr; const float sc = r[rl]; bf16_t* rowp = AUS + (size_t)((u.pm - 64) * BM + rl) * AUW + c0;
#pragma unroll
                    for (int bj = 0; bj < 2; ++bj) { const f32x4 v0 = acc[ai][bj][m][0] * sc, v1 = acc[ai][bj][m][1] * sc;
                        u32x4 o; o.x = cvt_pk_bf16(v0[0], v0[1]); o.y = cvt_pk_bf16(v0[2], v0[3]); o.z = cvt_pk_bf16(v1[0], v1[1]); o.w = cvt_pk_bf16(v1[2], v1[3]); *(u32x4*)(rowp + bj * FF) = o; } }
            return;
        }
        f32x4 w0[2], w1[2], w2[2], cbv[2];
#pragma unroll
        for (int n = 0; n < 2; ++n) { w0[n] = *(const f32x4*)(cw + c0 + 4 * n); w1[n] = *(const f32x4*)(cw + FF + c0 + 4 * n); w2[n] = *(const f32x4*)(cw + 2 * FF + c0 + 4 * n); cbv[n] = *(const f32x4*)(cb + c0 + 4 * n); }
#pragma unroll
        for (int ai = 0; ai < 2; ++ai) {
            const int rb = u.pm * 4 + ai * 2 + wr;
            f32x4 ap[2] = {(f32x4){0.f, 0.f, 0.f, 0.f}, (f32x4){0.f, 0.f, 0.f, 0.f}};
#pragma unroll
            for (int m = 0; m < 4; ++m) {
                const int rl = ai * HALF + wr * 64 + m * 16 + fr; const float sc = r[rl]; const size_t row = (size_t)u.pm * BM + rl;
                f32x4 a[2], uu[2];
#pragma unroll
                for (int n = 0; n < 2; ++n) { a[n] = acc[ai][0][m][n] * sc; uu[n] = acc[ai][1][m][n] * sc; }
                if (m == 0 && fr < 2) {
#pragma unroll
                    for (int n = 0; n < 2; ++n) { *(f32x4*)(HF + ((size_t)rb * 2 + fr) * FF + c0 + 4 * n) = a[n]; *(f32x4*)(HU + ((size_t)rb * 2 + fr) * FF + c0 + 4 * n) = uu[n]; } }
                if (m == 3 && fr >= 14) {
#pragma unroll
                    for (int n = 0; n < 2; ++n) *(f32x4*)(HL + ((size_t)rb * 2 + (fr - 14)) * FF + c0 + 4 * n) = a[n]; }
                unsigned gpk[4];
#pragma unroll
                for (int n = 0; n < 2; ++n) { f32x4 g;
#pragma unroll
                    for (int jp = 0; jp < 2; ++jp) {
                        const f32x2 cur = (f32x2){a[n][2 * jp], a[n][2 * jp + 1]}, pv = (f32x2){ap[n][2 * jp], ap[n][2 * jp + 1]};
                        f32x2 p1, p2; p1.x = dpp_shr1(dpp_ror1(pv.x), cur.x); p1.y = dpp_shr1(dpp_ror1(pv.y), cur.y); p2.x = dpp_shr2(dpp_ror2(pv.x), cur.x); p2.y = dpp_shr2(dpp_ror2(pv.y), cur.y);
                        const f32x2 cb2 = (f32x2){cbv[n][2 * jp], cbv[n][2 * jp + 1]}, w02 = (f32x2){w0[n][2 * jp], w0[n][2 * jp + 1]}, w12 = (f32x2){w1[n][2 * jp], w1[n][2 * jp + 1]}, w22 = (f32x2){w2[n][2 * jp], w2[n][2 * jp + 1]};
                        const f32x2 ac = cb2 + w02 * p2 + w12 * p1 + w22 * cur;
                        const f32x2 gg = gelu_t2(ac) * (f32x2){uu[n][2 * jp], uu[n][2 * jp + 1]};
                        g[2 * jp] = gg.x; g[2 * jp + 1] = gg.y; }
                    gpk[2 * n] = cvt_pk_bf16(g[0], g[1]); gpk[2 * n + 1] = cvt_pk_bf16(g[2], g[3]); }
                if (!(m == 0 && fr < 2)) *(u32x4*)(Gb + row * FF + c0) = (u32x4){gpk[0], gpk[1], gpk[2], gpk[3]};
                ap[0] = a[0]; ap[1] = a[1];
            }
        }
    }
};
struct EpiResid {
    bf16_t* XB; float* ss;
    __device__ __forceinline__ void operator()(const f32x4 (&acc)[2][2][4][2], const Unit& u, int ui, int wr, int wc, int fr, int fq) const {
        const size_t base = (size_t)(u.pm * BM + wr * 64 + fr) * 1024 + u.pn * BM + wc * 32 + 8 * fq;
        u32x4 xv[2][2];
#pragma unroll
        for (int bj = 0; bj < 2; ++bj) xv[0][bj] = *(const u32x4*)(XB + base + bj * HALF);
#pragma unroll
        for (int g = 0; g < 8; ++g) {
            const int ai = g >> 2, m = g & 3; const size_t off = base + (size_t)(ai * HALF + m * 16) * 1024;
            if (g < 7) { const int ai2 = (g + 1) >> 2, m2 = (g + 1) & 3; const size_t off2 = base + (size_t)(ai2 * HALF + m2 * 16) * 1024;
#pragma unroll
                for (int bj = 0; bj < 2; ++bj) xv[(g + 1) & 1][bj] = *(const u32x4*)(XB + off2 + bj * HALF); }
            float sq = 0.f;
#pragma unroll
            for (int bj = 0; bj < 2; ++bj) { const u32x4 xr = xv[g & 1][bj]; const f32x4 a0 = acc[ai][bj][m][0], a1 = acc[ai][bj][m][1];
                const float v0 = bflo(xr.x) + a0[0], v1 = bfhi(xr.x) + a0[1], v2 = bflo(xr.y) + a0[2], v3 = bfhi(xr.y) + a0[3];
                const float v4 = bflo(xr.z) + a1[0], v5 = bfhi(xr.z) + a1[1], v6 = bflo(xr.w) + a1[2], v7 = bfhi(xr.w) + a1[3];
                sq += v0 * v0 + v1 * v1 + v2 * v2 + v3 * v3 + v4 * v4 + v5 * v5 + v6 * v6 + v7 * v7;
                u32x4 o; o.x = cvt_pk_bf16(v0, v1); o.y = cvt_pk_bf16(v2, v3); o.z = cvt_pk_bf16(v4, v5); o.w = cvt_pk_bf16(v6, v7); *(u32x4*)(XB + off + bj * HALF) = o; }
            sq += __shfl_xor(sq, 16); sq += __shfl_xor(sq, 32);
            if (fq == 0) ss[(size_t)(u.pn * 4 + wc) * MTOK + u.pm * BM + ai * HALF + wr * 64 + m * 16 + fr] = sq;
        }
    }
};
}

constexpr int LDP = 136;
constexpr int TILE_B = 128 * LDP * 2;
__device__ __forceinline__ void stage_rows(LAS bf16_t* dst, const bf16_t* src, size_t ld, int tid) {
#pragma unroll
    for (int i = 0; i < 4; ++i) { const int idx = tid + 512 * i, r = idx >> 4, ch = idx & 15;
        const u32x4 v = *(const u32x4*)(src + (size_t)r * ld + ch * 8); *(LAS u32x4*)(dst + r * LDP + ch * 8) = v; }
}
template <bool SCALE>
__device__ __forceinline__ void stage_T(LAS bf16_t* dst, const bf16_t* src, size_t ld, LAS const float* wtok, int wid, int lane) {
    const int t0 = 2 * lane;
    float w0 = 1.f, w1 = 1.f; if (SCALE) { w0 = wtok[t0]; w1 = wtok[t0 + 1]; }
#pragma unroll
    for (int it = 0; it < 2; ++it) {
        const int fg = wid + 8 * it;
        const u32x4 va = *(const u32x4*)(src + (size_t)t0 * ld + fg * 8), vb = *(const u32x4*)(src + (size_t)(t0 + 1) * ld + fg * 8);
#pragma unroll
        for (int j = 0; j < 4; ++j) {
            unsigned lo, hi;
            if (SCALE) { lo = cvt_pk_bf16(bflo(va[j]) * w0, bflo(vb[j]) * w1); hi = cvt_pk_bf16(bfhi(va[j]) * w0, bfhi(vb[j]) * w1); }
            else { lo = (va[j] & 0xffffu) | (vb[j] << 16); hi = (va[j] >> 16) | (vb[j] & 0xffff0000u); }
            *(LAS unsigned*)(dst + (8 * fg + 2 * j) * LDP + t0) = lo;
            *(LAS unsigned*)(dst + (8 * fg + 2 * j + 1) * LDP + t0) = hi;
        }
    }
}
__device__ __forceinline__ void lds_gemm128(LAS const bf16_t* A, LAS const bf16_t* B, f32x4 (&acc)[2][4], int wr4, int wc2, int lane) {
    const int fr = lane & 15, fq = lane >> 4;
#pragma unroll
    for (int kk = 0; kk < 4; ++kk) {
        bf16x8 a[2], b[4];
#pragma unroll
        for (int mi = 0; mi < 2; ++mi) a[mi] = *(LAS const bf16x8*)(A + (32 * wr4 + 16 * mi + fr) * LDP + 32 * kk + 8 * fq);
#pragma unroll
        for (int ni = 0; ni < 4; ++ni) b[ni] = *(LAS const bf16x8*)(B + (64 * wc2 + 16 * ni + fr) * LDP + 32 * kk + 8 * fq);
#pragma unroll
        for (int mi = 0; mi < 2; ++mi)
#pragma unroll
            for (int ni = 0; ni < 4; ++ni) acc[mi][ni] = __builtin_amdgcn_mfma_f32_16x16x32_bf16(a[mi], b[ni], acc[mi][ni], 0, 0, 0);
    }
}
__device__ __forceinline__ void zero_acc(f32x4 (&acc)[2][4]) {
#pragma unroll
    for (int mi = 0; mi < 2; ++mi)
#pragma unroll
        for (int ni = 0; ni < 4; ++ni) acc[mi][ni] = (f32x4){0.f, 0.f, 0.f, 0.f};
}

__device__ __forceinline__ void transpose_item(CTJob& j, int item, LAS float* scr, int lane) {
    const int nblk = j.ncols / 32, kb = item / nblk, nb = item % nblk, k0 = 64 * kb, n0 = 32 * nb;
    float wv[32];
    const float* wp = j.W + (size_t)(k0 + (lane >> 5)) * j.ldw + n0 + (lane & 31);
#pragma unroll
    for (int i = 0; i < 32; ++i) wv[i] = wp[(size_t)(2 * i) * j.ldw];
    if (j.gk) {
#pragma unroll
        for (int i = 0; i < 32; ++i) wv[i] *= j.gk[k0 + 2 * i + (lane >> 5)]; }
#pragma unroll
    for (int i = 0; i < 32; ++i) scr[(2 * i + (lane >> 5)) * 33 + (lane & 31)] = wv[i];
    LDS_WAIT();
    const int c = lane & 7;
#pragma unroll
    for (int q = 0; q < 4; ++q) { const int n = (lane >> 3) + 8 * q; LAS const float* s = scr + (8 * c) * 33 + n;
        const int ng = n0 + n; const float sc = (ng >= j.n_lo && ng < j.n_hi) ? j.nscale : 1.f;
        u32x4 o; o.x = cvt_pk_bf16(s[0] * sc, s[33] * sc); o.y = cvt_pk_bf16(s[2 * 33] * sc, s[3 * 33] * sc); o.z = cvt_pk_bf16(s[4 * 33] * sc, s[5 * 33] * sc); o.w = cvt_pk_bf16(s[6 * 33] * sc, s[7 * 33] * sc);
        const int drow = j.rmode ? ((ng >> 7) * 256 + (ng & 127) + j.roff) : ng;
        *(u32x4*)(j.WT + (size_t)drow * j.ldt + k0 + 8 * c) = o; }
    LDS_WAIT();
}
__device__ __forceinline__ void phase_prep(CParams& P, LAS unsigned char* lds) {
    const int tid = get_tid(), wid = tid >> 6, lane = tid & 63;
    const int gw = get_bid() * 8 + wid, NGW = get_gdim() * 8;
    const int gt = get_bid() * 512 + tid, NGT = get_gdim() * 512;
    LAS float* scr = (LAS float*)(lds + wid * 8704);
#ifdef DEBUG_FILL
    { u32x4* bp = (u32x4*)(P.ws + WS_BIG); const size_t n16 = ((size_t)MTOK * AUW * 2) / 16; const u32x4 pv = (u32x4){DEBUG_FILL, DEBUG_FILL, DEBUG_FILL, DEBUG_FILL};
      for (size_t i = (size_t)get_bid() * 512 + tid; i < n16; i += (size_t)get_gdim() * 512) bp[i] = pv; }
#endif
    float* X = P.out; bf16_t* XB = (bf16_t*)(P.ws + WS_XB); float* SS = (float*)(P.ws + WS_SS);
    for (int row = gw; row < MTOK; row += NGW) {
        const float* src = row < MP ? P.in[0] + (size_t)row * 1024 : P.in[1] + (size_t)(row - MP) * 1024;
        float s = 0.f;
#pragma unroll
        for (int j = 0; j < 4; ++j) { const f32x4 v = *(const f32x4*)(src + 4 * lane + 256 * j);
            s += v[0] * v[0] + v[1] * v[1] + v[2] * v[2] + v[3] * v[3];
            u32x2 o; o.x = cvt_pk_bf16(v[0], v[1]); o.y = cvt_pk_bf16(v[2], v[3]); *(u32x2*)(XB + (size_t)row * 1024 + 4 * lane + 256 * j) = o; }
        s = wave_sum(s);
        if (lane < 16) SS[(size_t)lane * MTOK + row] = lane == 0 ? s : 0.f;
    }
    for (int it = gw; it < P.nitems; it += NGW) {
        int jb = 0;
#pragma unroll 1
        for (int q = 1; q < NJOBS; ++q) if (it >= P.jobs[q].item0) jb = q;
        transpose_item(P.jobs[jb], it - P.jobs[jb].item0, scr, lane);
    }
    float* WG = (float*)(P.ws + WS_WG);
    for (int i = gt; i < 2 * 8 * 1024; i += NGT) { const int e = i >> 13, j = (i >> 10) & 7, k = i & 1023;
        WG[i] = P.in[8][((size_t)e * 1024 + k) * 2568 + 2560 + j] * P.in[7][(2 * e) * 1024 + k]; }
    { bf16_t* WGB = (bf16_t*)(P.ws + WS_WGB);
      for (int i = gt; i < 2 * 16 * 1024 / 2; i += NGT) { const int i2 = i * 2, e = i2 >> 14, j = (i2 >> 10) & 15, k = i2 & 1023;
          float v0 = 0.f, v1 = 0.f;
          if (j < 8) { v0 = P.in[8][((size_t)e * 1024 + k) * 2568 + 2560 + j] * P.in[7][(2 * e) * 1024 + k]; v1 = P.in[8][((size_t)e * 1024 + k + 1) * 2568 + 2560 + j] * P.in[7][(2 * e) * 1024 + k + 1]; }
          *(unsigned*)(WGB + i2) = cvt_pk_bf16(v0, v1); } }
    bf16_t* WPOOL = (bf16_t*)(P.ws + WS_WPOOL);
    for (int i = gt; i < 2 * 4 * 128 * 128; i += NGT) { const int c = i & 127, d = (i >> 7) & 127, eg = i >> 14;
        const float mine = P.in[10][((size_t)eg * 128 + c) * 128 + d] * P.in[11][eg * 128 + d]; const float other = __shfl_xor(mine, 1);
        if (!(i & 1)) *(unsigned*)(WPOOL + i) = cvt_pk_bf16(mine, other); }
    bf16_t* WSP = (bf16_t*)(P.ws + WS_WSP);
    for (int i = gt; i < 2 * 4 * 128 * 128; i += NGT) { const int s = i & 127, r = (i >> 7) & 127;
        const float mine = s <= r ? P.in[17][i] : 0.f; const float other = __shfl_xor(mine, 1);
        if (!(i & 1)) *(unsigned*)(WSP + i) = cvt_pk_bf16(mine, other); }
}

__device__ __forceinline__ void phase_gates(CParams& P, int e, LAS unsigned char* lds) {
    const int tid = get_tid(), wid = tid >> 6, lane = tid & 63, fr = lane & 15, fq = lane >> 4;
    const bf16_t* XB = (const bf16_t*)(P.ws + WS_XB); const float* SS = (const float*)(P.ws + WS_SS); const bf16_t* WGB = (const bf16_t*)(P.ws + WS_WGB) + e * 16384;
    float* G = (float*)(P.ws + WS_BIG + B_GATES);
    LAS float* red = (LAS float*)lds;
    const int nbusy = (660 - 2 * get_gdim() > 0 && 660 - 2 * get_gdim() < get_gdim()) ? 660 - 2 * get_gdim() : 0;
    for (int u = get_bid() - nbusy; u < MTOK / 64; u += get_gdim() - nbusy) {
        if (u < 0) break;
        const int r0 = u * 64, k0 = wid * 128;
        f32x4 acc[4];
#pragma unroll
        for (int mi = 0; mi < 4; ++mi) acc[mi] = (f32x4){0.f, 0.f, 0.f, 0.f};
        bf16x8 a[4][4], b[4];
#pragma unroll
        for (int q = 0; q < 4; ++q) { b[q] = *(const bf16x8*)(WGB + (size_t)fr * 1024 + k0 + 32 * q + 8 * fq);
#pragma unroll
            for (int mi = 0; mi < 4; ++mi) a[q][mi] = *(const bf16x8*)(XB + (size_t)(r0 + 16 * mi + fr) * 1024 + k0 + 32 * q + 8 * fq); }
#pragma unroll
        for (int q = 0; q < 4; ++q)
#pragma unroll
            for (int mi = 0; mi < 4; ++mi) acc[mi] = __builtin_amdgcn_mfma_f32_16x16x32_bf16(a[q][mi], b[q], acc[mi], 0, 0, 0);
#pragma unroll
        for (int mi = 0; mi < 4; ++mi)
#pragma unroll
            for (int j = 0; j < 4; ++j) red[wid * 1024 + (16 * mi + 4 * fq + j) * 16 + fr] = acc[mi][j];
        __syncthreads();
        { const int row = tid >> 3, j = tid & 7;
          float v = 0.f;
#pragma unroll
          for (int w = 0; w < 8; ++w) v += red[w * 1024 + row * 16 + j];
          float s2 = 0.f;
#pragma unroll
          for (int q = 0; q < 16; ++q) s2 += SS[(size_t)q * MTOK + r0 + row];
          v = v * rsqrtf(s2 * (1.f / 1024.f) + EPS) + P.in[9][e * 8 + j];
          if (j >= 4) v = fminf(v, 0.f) - log1pf(__expf(-fabsf(v)));
          G[(size_t)(r0 + row) * 8 + j] = v; }
        __syncthreads();
    }
}

__device__ __forceinline__ void e2_unit(CParams& P, int unit, LAS unsigned char* lds) {
    const int tid = get_tid(), wid = tid >> 6, lane = tid & 63;
    const int b = unit >> 6, h = (unit >> 4) & 3, c = unit & 15;
    unsigned char* big = P.ws + WS_BIG;
    const bf16_t* ZB = (const bf16_t*)(big + B_ZB); const float* G = (const float*)(big + B_GATES);
    float* BT = (float*)(big + B_BT); float* SCAL = (float*)(big + B_SCAL); float* DC = (float*)(big + B_DC); float* DN = (float*)(big + B_DN);
    LAS bf16_t* VT = (LAS bf16_t*)lds; LAS bf16_t* KW = (LAS bf16_t*)(lds + TILE_B);
    LAS float* sB = (LAS float*)(lds + 2 * TILE_B); LAS float* sM = sB + 16; LAS float* sg = sB + 32; LAS float* sw = sB + 160;
    for (int cc = wid; cc <= c; cc += 8) {
        const size_t tb = (size_t)b * 2048 + cc * 128 + 2 * lane;
        const float lf0 = G[tb * 8 + 4 + h], lf1 = G[(tb + 1) * 8 + 4 + h], ig0 = G[tb * 8 + h], ig1 = G[(tb + 1) * 8 + h];
        const float pair = lf0 + lf1; float incl = pair;
#pragma unroll
        for (int o = 1; o < 64; o <<= 1) { const float t = __shfl_up(incl, o); if (lane >= o) incl += t; }
        const float b1 = incl, b0 = incl - lf1;
        const float Btot = __shfl(incl, 63);
        const float g0 = ig0 - b0, g1 = ig1 - b1; const float mx = wave_max(fmaxf(g0, g1));
        if (lane == 0) { sB[cc] = Btot; sM[cc] = Btot + mx; }
        if (cc == c) { sg[2 * lane] = g0; sg[2 * lane + 1] = g1; BT[tb * 4 + h] = b0; BT[(tb + 1) * 4 + h] = b1; }
    }
    __syncthreads();
    float m = 0.f, mprev = 0.f;
    for (int cc = 0; cc <= c; ++cc) { mprev = m; m = fmaxf(sB[cc] + m, sM[cc]); }
    const float Bc = sB[c];
    if (tid < 128) sw[tid] = __expf(Bc + sg[tid] - m);
    if (tid == 0) { SCAL[unit * 4 + 0] = mprev; SCAL[unit * 4 + 1] = m; SCAL[unit * 4 + 2] = Bc; }
    __syncthreads();
    const bf16_t* zrow = ZB + ((size_t)b * 2048 + c * 128) * NZ;
    stage_T<false>(VT, zrow + 1536 + h * 128, NZ, sw, wid, lane);
    stage_T<true>(KW, zrow + 1024 + h * 128, NZ, sw, wid, lane);
    __syncthreads();
    f32x4 acc[2][4]; zero_acc(acc);
    const int wr4 = wid >> 1, wc2 = wid & 1, fr = lane & 15, fq = lane >> 4;
    lds_gemm128(VT, KW, acc, wr4, wc2, lane);
    float* dc = DC + (size_t)unit * 16384;
#pragma unroll
    for (int mi = 0; mi < 2; ++mi)
#pragma unroll
        for (int ni = 0; ni < 4; ++ni)
#pragma unroll
            for (int j = 0; j < 4; ++j) dc[(32 * wr4 + 16 * mi + 4 * fq + j) * 128 + 64 * wc2 + 16 * ni + fr] = acc[mi][ni][j];
    if (tid < 128) { float s = 0.f;
#pragma unroll
        for (int i = 0; i < 16; ++i) { const u32x4 v = *(LAS const u32x4*)(KW + tid * LDP + 8 * i); float f[8]; unpack8(v, f);
#pragma unroll
            for (int q = 0; q < 8; ++q) s += f[q]; }
        DN[unit * 128 + tid] = s; }
    __syncthreads();
}

__device__ __forceinline__ void pool_unit(CParams& P, int e, int tile, int g, LAS unsigned char* lds) {
    const int tid = get_tid(), wid = tid >> 6, lane = tid & 63;
    unsigned char* big = P.ws + WS_BIG;
    const bf16_t* ZB = (const bf16_t*)(big + B_ZB); bf16_t* YMIX = (bf16_t*)(big + B_YMIX);
    const bf16_t* WPOOL = (const bf16_t*)(P.ws + WS_WPOOL) + (size_t)(e * 4 + g) * 16384;
    LAS bf16_t* A = (LAS bf16_t*)lds; LAS bf16_t* Bm = (LAS bf16_t*)(lds + TILE_B); LAS bf16_t* R = (LAS bf16_t*)(lds + 2 * TILE_B);
    const int w = 2 << g; const int tok0 = tile * 128;
    stage_rows(Bm, WPOOL, 128, tid);
    if (tile < 128) {
        const int tpos0 = tok0 & 2047;
        for (int idx = tid; idx < 143 * 16; idx += 512) { const int r = idx >> 4, ch = idx & 15;
            u32x4 v = (u32x4){0u, 0u, 0u, 0u};
            if (tpos0 - 15 + r >= 0) v = *(const u32x4*)(ZB + (size_t)(tok0 - 15 + r) * NZ + g * 128 + ch * 8);
            *(LAS u32x4*)(R + r * LDP + ch * 8) = v; }
        __syncthreads();
#pragma unroll 1
        for (int i = 0; i < 4; ++i) {
            const int idx = tid + 512 * i, t = idx >> 4, cg8 = idx & 15, tpos = tpos0 + t, col = g * 128 + cg8 * 8;
            float sum[8], self[8], f[8];
            unpack8(*(LAS const u32x4*)(R + (t + 15) * LDP + cg8 * 8), self);
#pragma unroll
            for (int q = 0; q < 8; ++q) sum[q] = self[q];
            for (int ii = 1; ii < w; ++ii) { unpack8(*(LAS const u32x4*)(R + (t + 15 - ii) * LDP + cg8 * 8), f);
#pragma unroll
                for (int q = 0; q < 8; ++q) sum[q] += f[q]; }
            if (tpos >= 2033) { float* o = P.out + O_POOLP + ((size_t)(e * 8 + (tok0 >> 11)) * 15 + (tpos - 2033)) * 512 + col;
                *(f32x4*)o = (f32x4){self[0], self[1], self[2], self[3]}; *(f32x4*)(o + 4) = (f32x4){self[4], self[5], self[6], self[7]}; }
            const float ic = 1.f / (float)min(w, tpos + 1); float d[8];
#pragma unroll
            for (int q = 0; q < 8; ++q) d[q] = sum[q] * ic - self[q];
            *(LAS u32x4*)(A + t * LDP + cg8 * 8) = pack8(d);
        }
    } else {
        const int seq = tid >> 4, cg8 = tid & 15, col = g * 128 + cg8 * 8; const int bs = ((tok0 - MP) >> 2) + seq;
        const float* sp = P.in[2] + ((size_t)(e * 128 + bs) * 15) * 512 + col;
        float* ob = P.out + O_POOLS + ((size_t)(e * 128 + bs) * 15) * 512 + col;
        float run[8], lo[4][8], hi[4][8], self[4][8];
#pragma unroll
        for (int q = 0; q < 8; ++q) { run[q] = 0.f;
#pragma unroll
            for (int t = 0; t < 4; ++t) lo[t][q] = 0.f; }
#pragma unroll
        for (int k = 0; k < 19; ++k) {
            float row[8];
            if (k < 15) { const f32x4 r0 = *(const f32x4*)(sp + (size_t)k * 512), r1 = *(const f32x4*)(sp + (size_t)k * 512 + 4);
                row[0] = r0[0]; row[1] = r0[1]; row[2] = r0[2]; row[3] = r0[3]; row[4] = r1[0]; row[5] = r1[1]; row[6] = r1[2]; row[7] = r1[3]; }
            else unpack8(*(const u32x4*)(ZB + (size_t)(MP + bs * 4 + (k - 15)) * NZ + col), row);
            if (k >= 4) { float* o = ob + (size_t)(k - 4) * 512; *(f32x4*)o = (f32x4){row[0], row[1], row[2], row[3]}; *(f32x4*)(o + 4) = (f32x4){row[4], row[5], row[6], row[7]}; }
#pragma unroll
            for (int q = 0; q < 8; ++q) run[q] += row[q];
#pragma unroll
            for (int t = 0; t < 4; ++t) {
                if (k == 15 + t - w) {
#pragma unroll
                    for (int q = 0; q < 8; ++q) lo[t][q] = run[q]; }
                if (k == 15 + t) {
#pragma unroll
                    for (int q = 0; q < 8; ++q) { hi[t][q] = run[q]; self[t][q] = row[q]; } }
            }
        }
        const float ic = 1.f / (float)w;
#pragma unroll
        for (int t = 0; t < 4; ++t) { float d[8];
#pragma unroll
            for (int q = 0; q < 8; ++q) d[q] = (hi[t][q] - lo[t][q]) * ic - self[t][q];
            *(LAS u32x4*)(A + (seq * 4 + t) * LDP + cg8 * 8) = pack8(d); }
    }
    __syncthreads();
    f32x4 acc[2][4]; zero_acc(acc);
    const int wr4 = wid >> 1, wc2 = wid & 1, fr = lane & 15, fq = lane >> 4;
    lds_gemm128(A, Bm, acc, wr4, wc2, lane);
#pragma unroll
    for (int mi = 0; mi < 2; ++mi)
#pragma unroll
        for (int ni = 0; ni < 4; ++ni)
#pragma unroll
            for (int j = 0; j < 4; ++j) { const float mine = acc[mi][ni][j]; const float other = __shfl_xor(mine, 1);
                if (!(fr & 1)) *(unsigned*)(YMIX + (size_t)(tok0 + 32 * wr4 + 16 * mi + 4 * fq + j) * 1024 + g * 128 + 64 * wc2 + 16 * ni + fr) = cvt_pk_bf16(mine, other); }
    __syncthreads();
}

__device__ __forceinline__ void phase_scan(CParams& P, int e, LAS unsigned char* lds) {
    unsigned char* big = P.ws + WS_BIG;
    const float* SCAL = (const float*)(big + B_SCAL); const float* DC = (const float*)(big + B_DC); const float* DN = (const float*)(big + B_DN);
    bf16_t* CPREV = (bf16_t*)(big + B_CPREV); float* NPREV = (float*)(big + B_NPREV);
    const int gt = get_bid() * 512 + get_tid(), NGT = get_gdim() * 512;
    for (int i = gt; i < 32 * 4096; i += NGT) {
        const int bh = i >> 12, e4 = (i & 4095) * 4;
        f32x4 st = (f32x4){0.f, 0.f, 0.f, 0.f}; f32x4 dcv[16]; float aLv[16];
#pragma unroll
        for (int c = 0; c < 16; ++c) { const int unit = bh * 16 + c; dcv[c] = *(const f32x4*)(DC + (size_t)unit * 16384 + e4);
            aLv[c] = __expf(SCAL[unit * 4 + 2] + SCAL[unit * 4 + 0] - SCAL[unit * 4 + 1]); }
#pragma unroll
        for (int c = 0; c < 16; ++c) {
            const int unit = bh * 16 + c;
            u32x2 o; o.x = cvt_pk_bf16(st[0], st[1]); o.y = cvt_pk_bf16(st[2], st[3]); *(u32x2*)(CPREV + (size_t)unit * 16384 + e4) = o;
            st = st * aLv[c] + dcv[c];
        }
        const int v = e4 >> 7, k = e4 & 127;
        float* o = P.out + O_CP + ((size_t)(e * 32 + bh) * 128) * 128;
        if (NGT == 32 * 4096) {
            LAS float* T = (LAS float*)lds; const int tid = i & 511, vl = tid >> 5;
            *(LAS f32x4*)(T + vl * 132 + k) = st;
            __syncthreads();
            const int k2 = tid >> 2, vq = tid & 3; const int v0 = (e4 >> 7) - vl;
            f32x4 t4; t4[0] = T[(4 * vq + 0) * 132 + k2]; t4[1] = T[(4 * vq + 1) * 132 + k2]; t4[2] = T[(4 * vq + 2) * 132 + k2]; t4[3] = T[(4 * vq + 3) * 132 + k2];
            *(f32x4*)(o + (size_t)k2 * 128 + v0 + 4 * vq) = t4;
            __syncthreads();
        } else {
#pragma unroll
            for (int q = 0; q < 4; ++q) o[(size_t)(k + q) * 128 + v] = st[q];
        }
    }
    for (int i = gt; i < 32 * 128; i += NGT) {
        const int bh = i >> 7, k = i & 127; float st = 0.f;
        for (int c = 0; c < 16; ++c) { const int unit = bh * 16 + c; NPREV[unit * 128 + k] = st;
            const float aL = __expf(SCAL[unit * 4 + 2] + SCAL[unit * 4 + 0] - SCAL[unit * 4 + 1]); st = st * aL + DN[unit * 128 + k]; }
        P.out[O_NP + (size_t)(e * 32 + bh) * 128 + k] = st;
    }
    if (gt < 32) P.out[O_MP + e * 32 + gt] = SCAL[(gt * 16 + 15) * 4 + 1];
}
__device__ __forceinline__ void mlstm_sample_unit(CParams& P, int e, int unit, LAS unsigned char* lds) {
    const int tid = get_tid(), lane = tid & 63;
    const int bs = unit >> 2, h = unit & 3; const int tokS = MP + bs * 4;
    unsigned char* big = P.ws + WS_BIG;
    const bf16_t* ZB = (const bf16_t*)(big + B_ZB); const float* G = (const float*)(big + B_GATES); bf16_t* YMIX = (bf16_t*)(big + B_YMIX);
    LAS float* sq = (LAS float*)lds; LAS float* sk = sq + 512; LAS float* sv = sq + 1024; LAS float* swk = sq + 1536; LAS float* sqc = sq + 2048;
    LAS float* sS = sq + 4096; LAS float* sqn = sS + 16; LAS float* shs = sqn + 4;
    const size_t sidx = (size_t)(e * 128 + bs) * 4 + h;
    const float* C0 = P.in[3] + sidx * 16384; const float* n0 = P.in[4] + sidx * 128; const float m0 = P.in[5][sidx];
    for (int idx = tid; idx < 1536; idx += 512) { const int which = idx >> 9, t = (idx >> 7) & 3, f = idx & 127;
        sq[idx] = bf2f(ZB[(size_t)(tokS + t) * NZ + 512 + which * 512 + h * 128 + f]); }
    float ig[4], bb[4], mt[4], at[4]; float cs = 0.f;
#pragma unroll
    for (int t = 0; t < 4; ++t) { ig[t] = G[(size_t)(tokS + t) * 8 + h]; cs += G[(size_t)(tokS + t) * 8 + 4 + h]; bb[t] = cs; }
#pragma unroll
    for (int t = 0; t < 4; ++t) { float mm = bb[t] + m0;
#pragma unroll
        for (int s = 0; s < 4; ++s) if (s <= t) mm = fmaxf(mm, bb[t] - bb[s] + ig[s]);
        mt[t] = mm; at[t] = __expf(bb[t] + m0 - mm); }
    const float mnew = mt[3]; const float aL = __expf(bb[3] + m0 - mnew);
    float ws[4];
#pragma unroll
    for (int s = 0; s < 4; ++s) ws[s] = __expf(bb[3] - bb[s] + ig[s] - mnew);
    __syncthreads();
    {
        const int p = tid >> 5, l32 = tid & 31, t = p >> 2, s = p & 3;
        float d = 0.f;
#pragma unroll
        for (int q = 0; q < 4; ++q) d += sq[t * 128 + l32 * 4 + q] * sk[s * 128 + l32 * 4 + q];
#pragma unroll
        for (int o = 1; o < 32; o <<= 1) d += __shfl_xor(d, o);
        float bt = 0.f, bsv = 0.f, igs = 0.f, mtt = 0.f;
#pragma unroll
        for (int q = 0; q < 4; ++q) { if (q == t) { bt = bb[q]; mtt = mt[q]; } if (q == s) { bsv = bb[q]; igs = ig[q]; } }
        if (l32 == 0) sS[p] = (s <= t) ? d * __expf(bt - bsv + igs - mtt) : 0.f;
        if (p < 4) { float d2 = 0.f;
#pragma unroll
            for (int q = 0; q < 4; ++q) d2 += sq[p * 128 + l32 * 4 + q] * n0[l32 * 4 + q];
#pragma unroll
            for (int o = 1; o < 32; o <<= 1) d2 += __shfl_xor(d2, o);
            if (l32 == 0) sqn[p] = d2; }
        const int s2 = tid >> 7, k2 = tid & 127; float wv = 0.f;
#pragma unroll
        for (int q = 0; q < 4; ++q) if (q == s2) wv = ws[q];
        swk[tid] = wv * sk[s2 * 128 + k2];
    }
    __syncthreads();
    {
        const int v = tid & 127, kq = tid >> 7; float qc[4] = {0.f, 0.f, 0.f, 0.f};
        float* Co = P.out + O_CS + sidx * 16384;
        const float v0 = sv[v], v1 = sv[128 + v], v2 = sv[256 + v], v3 = sv[384 + v];
#pragma unroll 1
        for (int kb = 0; kb < 32; kb += 16) {
            float c0v[16];
#pragma unroll
            for (int kk = 0; kk < 16; ++kk) c0v[kk] = C0[(kq * 32 + kb + kk) * 128 + v];
#pragma unroll
            for (int kk = 0; kk < 16; ++kk) { const int k = kq * 32 + kb + kk; const float c0 = c0v[kk];
                Co[k * 128 + v] = aL * c0 + swk[k] * v0 + swk[128 + k] * v1 + swk[256 + k] * v2 + swk[384 + k] * v3;
#pragma unroll
                for (int t = 0; t < 4; ++t) qc[t] += sq[t * 128 + k] * c0; }
        }
#pragma unroll
        for (int t = 0; t < 4; ++t) sqc[(kq * 4 + t) * 128 + v] = qc[t];
        if (tid < 128) P.out[O_NS + sidx * 128 + tid] = aL * n0[tid] + swk[tid] + swk[128 + tid] + swk[256 + tid] + swk[384 + tid];
        if (tid == 0) P.out[O_MS + sidx] = mnew;
    }
    __syncthreads();
    const int t = tid >> 7, v = tid & 127;
    float att = 0.f, mtt = 0.f;
#pragma unroll
    for (int q = 0; q < 4; ++q) if (q == t) { att = at[q]; mtt = mt[q]; }
    const float qC = sqc[(0 * 4 + t) * 128 + v] + sqc[(1 * 4 + t) * 128 + v] + sqc[(2 * 4 + t) * 128 + v] + sqc[(3 * 4 + t) * 128 + v];
    float den = att * sqn[t], num = att * qC;
#pragma unroll
    for (int s = 0; s < 4; ++s) { const float Sv = sS[t * 4 + s]; den += Sv; num += Sv * sv[s * 128 + v]; }
    const float hv = num / fmaxf(fabsf(den), __expf(-mtt));
    const float hsq = wave_sum(hv * hv);
    if (lane == 0) shs[t * 2 + ((tid >> 6) & 1)] = hsq;
    __syncthreads();
    const float rn = rsqrtf((shs[t * 2] + shs[t * 2 + 1]) * (1.f / 128.f) + EPS);
    const int col = h * 128 + v;
    const float o = bf2f(ZB[(size_t)(tokS + t) * NZ + 2048 + col]);
    { const float mine = sigmoidf_(o) * hv * rn * P.in[12][e * 512 + col]; const float other = __shfl_xor(mine, 1);
      if (!(v & 1)) *(unsigned*)(YMIX + (size_t)(tokS + t) * 1024 + 512 + col) = cvt_pk_bf16(mine, other); }
    __syncthreads();
}

__device__ __forceinline__ void e4_unit(CParams& P, int e, int unit, LAS unsigned char* lds) {
    const int tid = get_tid(), wid = tid >> 6, lane = tid & 63;
    const int b = unit >> 6, h = (unit >> 4) & 3, c = unit & 15; const int tok0 = b * 2048 + c * 128;
    unsigned char* big = P.ws + WS_BIG;
    const bf16_t* ZB = (const bf16_t*)(big + B_ZB); const float* G = (const float*)(big + B_GATES);
    const float* BT = (const float*)(big + B_BT); const float* SCAL = (const float*)(big + B_SCAL);
    const bf16_t* CPREV = (const bf16_t*)(big + B_CPREV); const float* NPREV = (const float*)(big + B_NPREV); bf16_t* YMIX = (bf16_t*)(big + B_YMIX);
    LAS bf16_t* Q = (LAS bf16_t*)lds; LAS bf16_t* Kb = (LAS bf16_t*)(lds + TILE_B); LAS bf16_t* VT = (LAS bf16_t*)(lds + 2 * TILE_B); LAS bf16_t* CT = (LAS bf16_t*)(lds + 3 * TILE_B);
    LAS float* sm = (LAS float*)(lds + 4 * TILE_B);
    LAS float* sgs = sm; LAS float* smt = sm + 128; LAS float* set = sm + 256; LAS float* sat = sm + 384; LAS float* rsum = sm + 512  ;
    LAS float* hs = sm + 768  ; LAS float* sdinv = sm + 1024; LAS float* sqn = sm + 1152; LAS float* snp = sm + 1280; LAS float* sbt = sm + 1408;
    const bf16_t* zrow = ZB + (size_t)tok0 * NZ;
    stage_rows(Q, zrow + 512 + h * 128, NZ, tid);
    stage_rows(Kb, zrow + 1024 + h * 128, NZ, tid);
    stage_T<false>(VT, zrow + 1536 + h * 128, NZ, sm, wid, lane);
    stage_rows(CT, CPREV + (size_t)unit * 16384, 128, tid);
    const float mprev = SCAL[unit * 4 + 0];
    if (tid < 128) { const float bt = BT[(size_t)(tok0 + tid) * 4 + h], igv = G[(size_t)(tok0 + tid) * 8 + h]; sbt[tid] = bt; sgs[tid] = igv - bt; snp[tid] = NPREV[unit * 128 + tid]; }
    __syncthreads();
    if (tid < 128) {
        float cm = sgs[tid];
#pragma unroll
        for (int o = 1; o < 64; o <<= 1) { const float t2 = __shfl_up(cm, o); if (lane >= o) cm = fmaxf(cm, t2); }
        if (tid >= 64) { float m0 = sgs[lane]; m0 = wave_max(m0); cm = fmaxf(cm, m0); }
        const float bt = sbt[tid]; const float mt = bt + fmaxf(mprev, cm);
        smt[tid] = mt; set[tid] = bt - mt; sat[tid] = __expf(bt + mprev - mt);
        float qn = 0.f;
#pragma unroll
        for (int i = 0; i < 16; ++i) { float f[8]; unpack8(*(LAS const u32x4*)(Q + tid * LDP + 8 * i), f);
#pragma unroll
            for (int q = 0; q < 8; ++q) qn += f[q] * snp[8 * i + q]; }
        sqn[tid] = qn;
    }
    const int wr4 = wid >> 1, wc2 = wid & 1, fr = lane & 15, fq = lane >> 4;
    f32x4 acc1[2][4]; zero_acc(acc1);
    lds_gemm128(Q, Kb, acc1, wr4, wc2, lane);
    __syncthreads();
#pragma unroll
    for (int mi = 0; mi < 2; ++mi)
#pragma unroll
        for (int j = 0; j < 4; ++j) {
            const int t = 32 * wr4 + 16 * mi + 4 * fq + j; const float et = set[t]; float rs = 0.f;
#pragma unroll
            for (int ni = 0; ni < 4; ++ni) { const int s = 64 * wc2 + 16 * ni + fr;
                const float p = (s <= t) ? acc1[mi][ni][j] * __expf(et + sgs[s]) : 0.f; rs += p; const float po = __shfl_xor(p, 1);
                if (!(fr & 1)) *(LAS unsigned*)(Kb + t * LDP + s) = cvt_pk_bf16(p, po); }
            rs += __shfl_xor(rs, 1); rs += __shfl_xor(rs, 2); rs += __shfl_xor(rs, 4); rs += __shfl_xor(rs, 8);
            if (fr == 0) rsum[wc2 * 128 + t] = rs;
        }
    __syncthreads();
    if (tid < 128) { const float den = sat[tid] * sqn[tid] + rsum[tid] + rsum[128 + tid]; sdinv[tid] = 1.f / fmaxf(fabsf(den), __expf(-smt[tid])); }
    f32x4 acc2[2][4]; zero_acc(acc1); zero_acc(acc2);
    bf16_t og[2][4][4]; float gh[4];
#pragma unroll
    for (int ni = 0; ni < 4; ++ni) gh[ni] = P.in[12][e * 512 + h * 128 + 64 * wc2 + 16 * ni + fr];
#pragma unroll
    for (int mi = 0; mi < 2; ++mi)
#pragma unroll
        for (int j = 0; j < 4; ++j)
#pragma unroll
            for (int ni = 0; ni < 4; ++ni) og[mi][j][ni] = ZB[(size_t)(tok0 + 32 * wr4 + 16 * mi + 4 * fq + j) * NZ + 2048 + h * 128 + 64 * wc2 + 16 * ni + fr];
    lds_gemm128(Kb, VT, acc1, wr4, wc2, lane);
    lds_gemm128(Q, CT, acc2, wr4, wc2, lane);
    __syncthreads();
#pragma unroll
    for (int mi = 0; mi < 2; ++mi)
#pragma unroll
        for (int j = 0; j < 4; ++j) {
            const int t = 32 * wr4 + 16 * mi + 4 * fq + j; const float a = sat[t], di = sdinv[t]; float sq = 0.f;
#pragma unroll
            for (int ni = 0; ni < 4; ++ni) { const float hv = (a * acc2[mi][ni][j] + acc1[mi][ni][j]) * di; acc1[mi][ni][j] = hv; sq += hv * hv; }
            sq += __shfl_xor(sq, 1); sq += __shfl_xor(sq, 2); sq += __shfl_xor(sq, 4); sq += __shfl_xor(sq, 8);
            if (fr == 0) hs[wc2 * 128 + t] = sq;
        }
    __syncthreads();
#pragma unroll
    for (int mi = 0; mi < 2; ++mi)
#pragma unroll
        for (int j = 0; j < 4; ++j) {
            const int t = 32 * wr4 + 16 * mi + 4 * fq + j; const float rn = rsqrtf((hs[t] + hs[128 + t]) * (1.f / 128.f) + EPS);
#pragma unroll
            for (int ni = 0; ni < 4; ++ni) { const int col = h * 128 + 64 * wc2 + 16 * ni + fr;
                const float mine = sigmoidf_(bf2f(og[mi][j][ni])) * acc1[mi][ni][j] * rn * gh[ni]; const float other = __shfl_xor(mine, 1);
                if (!(fr & 1)) *(unsigned*)(YMIX + (size_t)(tok0 + t) * 1024 + 512 + col) = cvt_pk_bf16(mine, other); }
        }
    __syncthreads();
}

__device__ __forceinline__ void sgu_unit(CParams& P, int o, int unit, LAS unsigned char* lds) {
    const int tid = get_tid(), wid = tid >> 6, lane = tid & 63;
    const int g = unit & 3, tile = unit >> 2; const int tok0 = tile * 128;
    unsigned char* big = P.ws + WS_BIG;
    const bf16_t* U = (const bf16_t*)(big + B_U); const bf16_t* VPRE = (const bf16_t*)(big + B_VPRE); const float* LNS = (const float*)(big + B_LNS); bf16_t* US = (bf16_t*)(big + B_US);
    const bf16_t* WSP = (const bf16_t*)(P.ws + WS_WSP) + (size_t)(o * 4 + g) * 16384;
    LAS bf16_t* A = (LAS bf16_t*)lds; LAS bf16_t* B0 = (LAS bf16_t*)(lds + TILE_B); LAS bf16_t* B1 = (LAS bf16_t*)(lds + 2 * TILE_B);
    LAS float* smu = (LAS float*)(lds + 3 * TILE_B); LAS float* srs = smu + 128;
    stage_rows(A, WSP, 128, tid);
    if (tid < 128) { float s = 0.f, q = 0.f;
#pragma unroll
        for (int j = 0; j < 16; ++j) { s += LNS[(size_t)j * MTOK + tok0 + tid]; q += LNS[(size_t)(16 + j) * MTOK + tok0 + tid]; }
        const float mu = s * (1.f / 1024.f); smu[tid] = mu; srs[tid] = rsqrtf(fmaxf(q * (1.f / 1024.f) - mu * mu, 0.f) + EPS); }
    __syncthreads();
    {
        const int t0 = 2 * lane; const float mu0 = smu[t0], mu1 = smu[t0 + 1], r0 = srs[t0], r1 = srs[t0 + 1];
#pragma unroll
        for (int half = 0; half < 2; ++half) {
            LAS bf16_t* dst = half ? B1 : B0;
#pragma unroll
            for (int it = 0; it < 2; ++it) {
                const int fg = wid + 8 * it; const int ch0 = g * 256 + half * 128 + fg * 8;
                float fa[8], fb[8];
                unpack8(*(const u32x4*)(VPRE + (size_t)(tok0 + t0) * 1024 + ch0), fa); unpack8(*(const u32x4*)(VPRE + (size_t)(tok0 + t0 + 1) * 1024 + ch0), fb);
                const f32x4 lg0 = *(const f32x4*)(P.in[15] + o * 1024 + ch0), lg1 = *(const f32x4*)(P.in[15] + o * 1024 + ch0 + 4), lb0 = *(const f32x4*)(P.in[16] + o * 1024 + ch0), lb1 = *(const f32x4*)(P.in[16] + o * 1024 + ch0 + 4);
#pragma unroll
                for (int q = 0; q < 8; ++q) { const float lg = q < 4 ? lg0[q & 3] : lg1[q & 3], lb = q < 4 ? lb0[q & 3] : lb1[q & 3];
                    *(LAS unsigned*)(dst + (8 * fg + q) * LDP + t0) = cvt_pk_bf16((fa[q] - mu0) * r0 * lg + lb, (fb[q] - mu1) * r1 * lg + lb); }
            }
        }
    }
    __syncthreads();
    const int wr4 = wid >> 1, wc2 = wid & 1, fr = lane & 15, fq = lane >> 4;
    f32x4 acc0[2][4], acc1[2][4]; zero_acc(acc0); zero_acc(acc1);
    lds_gemm128(A, B0, acc0, wr4, wc2, lane);
    lds_gemm128(A, B1, acc1, wr4, wc2, lane);
#pragma unroll
    for (int mi = 0; mi < 2; ++mi) {
        bf16_t uv[4][4][2]; float bsr[4];
#pragma unroll
        for (int j = 0; j < 4; ++j) { const int r = 32 * wr4 + 16 * mi + 4 * fq + j; bsr[j] = P.in[18][(o * 4 + g) * 128 + r]; const size_t rowo = (size_t)(tok0 + r) * 1024 + g * 256;
#pragma unroll
            for (int ni = 0; ni < 4; ++ni) { const int d = 64 * wc2 + 16 * ni + fr; uv[j][ni][0] = U[rowo + d]; uv[j][ni][1] = U[rowo + 128 + d]; } }
#pragma unroll
        for (int j = 0; j < 4; ++j) {
            const int r = 32 * wr4 + 16 * mi + 4 * fq + j; const float bsv = bsr[j]; const size_t rowo = (size_t)(tok0 + r) * 1024 + g * 256;
#pragma unroll
            for (int ni = 0; ni < 4; ++ni) { const int d = 64 * wc2 + 16 * ni + fr;
                const float m0 = bf2f(uv[j][ni][0]) * (acc0[mi][ni][j] + bsv), m1 = bf2f(uv[j][ni][1]) * (acc1[mi][ni][j] + bsv);
                const float o0 = __shfl_xor(m0, 1), o1 = __shfl_xor(m1, 1);
                if (!(fr & 1)) { *(unsigned*)(US + rowo + d) = cvt_pk_bf16(m0, o0); *(unsigned*)(US + rowo + 128 + d) = cvt_pk_bf16(m1, o1); } }
        }
    }
    __syncthreads();
}
__device__ __forceinline__ void sgu_sample(CParams& P, int o) {
    const int tid = get_tid(), wid = tid >> 6, lane = tid & 63;
    const int gw = get_bid() * 8 + wid, NGW = get_gdim() * 8;
    unsigned char* big = P.ws + WS_BIG;
    const bf16_t* U = (const bf16_t*)(big + B_U); const bf16_t* VPRE = (const bf16_t*)(big + B_VPRE); const float* LNS = (const float*)(big + B_LNS); bf16_t* US = (bf16_t*)(big + B_US);
    for (int bs = gw; bs < 128; bs += NGW) {
        const int tokS = MP + bs * 4; float mu[4], rs[4];
#pragma unroll
        for (int t = 0; t < 4; ++t) { float s = lane < 16 ? LNS[(size_t)lane * MTOK + tokS + t] : 0.f, q = lane < 16 ? LNS[(size_t)(16 + lane) * MTOK + tokS + t] : 0.f;
            s = wave_sum(s); q = wave_sum(q); mu[t] = s * (1.f / 1024.f); rs[t] = rsqrtf(fmaxf(q * (1.f / 1024.f) - mu[t] * mu[t], 0.f) + EPS); }
        for (int i = 0; i < 16; ++i) { const int d = lane + 64 * i, g = d >> 8; const float lg = P.in[15][o * 1024 + d], lb = P.in[16][o * 1024 + d];
            float vl[4];
#pragma unroll
            for (int t = 0; t < 4; ++t) { vl[t] = (bf2f(VPRE[(size_t)(tokS + t) * 1024 + d]) - mu[t]) * rs[t] * lg + lb;
                P.out[O_V + ((size_t)(o * 128 + bs) * 4 + t) * 1024 + d] = vl[t]; }
#pragma unroll
            for (int t = 0; t < 4; ++t) { float s = P.in[18][(o * 4 + g) * 128 + t];
#pragma unroll
                for (int s2 = 0; s2 < 4; ++s2) if (s2 <= t) s += P.in[17][((size_t)(o * 4 + g) * 128 + t) * 128 + s2] * vl[s2];
                const float mine = bf2f(U[(size_t)(tokS + t) * 1024 + d]) * s; const float other = __shfl_xor(mine, 1);
                if (!(lane & 1)) *(unsigned*)(US + (size_t)(tokS + t) * 1024 + d) = cvt_pk_bf16(mine, other); }
        }
    }
}

__device__ __forceinline__ void conv_item(const float (&e0)[8], const float (&e1)[8], const float (&a2)[8], const float (&uu)[8], LAS const float* wl, int n, bf16_t* dst) {
    float gq[8];
#pragma unroll
    for (int h4 = 0; h4 < 2; ++h4) {
        const f32x4 w0 = *(LAS const f32x4*)(wl + n + 4 * h4), w1 = *(LAS const f32x4*)(wl + FF + n + 4 * h4), w2 = *(LAS const f32x4*)(wl + 2 * FF + n + 4 * h4), cb = *(LAS const f32x4*)(wl + 3 * FF + n + 4 * h4);
#pragma unroll
        for (int q = 0; q < 4; ++q) { const int i = 4 * h4 + q; const float ac = cb[q] + w0[q] * e0[i] + w1[q] * e1[i] + w2[q] * a2[i]; gq[i] = gelu_t(ac) * uu[i]; }
    }
    *(u32x4*)dst = pack8(gq);
}
__device__ __forceinline__ void phase_conv(CParams& P, int l, LAS unsigned char* lds) {
    unsigned char* big = P.ws + WS_BIG;
    bf16_t* Gb = (bf16_t*)(big + B_G); bf16_t* AUS = (bf16_t*)(big + B_AUS);
    const float* HF = (const float*)(big + B_HF); const float* HU = (const float*)(big + B_HU); const float* HL = (const float*)(big + B_HL);
    const int tid = get_tid();
    const int gt = get_bid() * 512 + tid, NGT = get_gdim() * 512;
    LAS float* wl = (LAS float*)lds;
    for (int i = tid; i < 3 * FF; i += 512) wl[i] = P.in[23][(size_t)l * 3 * FF + i];
    for (int i = tid; i < FF; i += 512) wl[3 * FF + i] = P.in[24][(size_t)l * FF + i];
    __syncthreads();
    for (int it = gt; it < 256 * 2 * 352; it += NGT) {
        const int c8 = it % 352, i = (it / 352) & 1, rb = it / 704, n = c8 * 8;
        float a2[8], uu[8], e0[8], e1[8];
        { const float* p = HF + ((size_t)rb * 2 + i) * FF + n; const f32x4 x0 = *(const f32x4*)p, x1 = *(const f32x4*)(p + 4);
          a2[0] = x0[0]; a2[1] = x0[1]; a2[2] = x0[2]; a2[3] = x0[3]; a2[4] = x1[0]; a2[5] = x1[1]; a2[6] = x1[2]; a2[7] = x1[3]; }
        { const float* p = HU + ((size_t)rb * 2 + i) * FF + n; const f32x4 x0 = *(const f32x4*)p, x1 = *(const f32x4*)(p + 4);
          uu[0] = x0[0]; uu[1] = x0[1]; uu[2] = x0[2]; uu[3] = x0[3]; uu[4] = x1[0]; uu[5] = x1[1]; uu[6] = x1[2]; uu[7] = x1[3]; }
        const bool first = (rb & 31) == 0;
        const float* p1 = i == 0 ? (first ? nullptr : HL + ((size_t)(rb - 1) * 2 + 1) * FF + n) : HF + ((size_t)rb * 2) * FF + n;
        const float* p0 = i == 0 ? (first ? nullptr : HL + ((size_t)(rb - 1) * 2 + 0) * FF + n) : (first ? nullptr : HL + ((size_t)(rb - 1) * 2 + 1) * FF + n);
#pragma unroll
        for (int q = 0; q < 8; ++q) { e1[q] = 0.f; e0[q] = 0.f; }
        if (p1) { const f32x4 x0 = *(const f32x4*)p1, x1 = *(const f32x4*)(p1 + 4); e1[0] = x0[0]; e1[1] = x0[1]; e1[2] = x0[2]; e1[3] = x0[3]; e1[4] = x1[0]; e1[5] = x1[1]; e1[6] = x1[2]; e1[7] = x1[3]; }
        if (p0) { const f32x4 x0 = *(const f32x4*)p0, x1 = *(const f32x4*)(p0 + 4); e0[0] = x0[0]; e0[1] = x0[1]; e0[2] = x0[2]; e0[3] = x0[3]; e0[4] = x1[0]; e0[5] = x1[1]; e0[6] = x1[2]; e0[7] = x1[3]; }
        conv_item(e0, e1, a2, uu, wl, n, Gb + ((size_t)rb * 64 + i) * FF + n);
    }
    for (int it = gt; it < 8 * 2 * 704; it += NGT) { const int c4 = (it % 704) * 4, j = (it / 704) & 1, b = it / 1408;
        *(f32x4*)(P.out + O_CONVP + ((size_t)(l * 8 + b) * 2 + j) * FF + c4) = *(const f32x4*)(HL + ((size_t)(b * 32 + 31) * 2 + j) * FF + c4); }
    for (int it = gt; it < 512 * 352; it += NGT) {
        const int srow = it / 352, n = (it % 352) * 8;
        const bf16_t* row = AUS + (size_t)srow * AUW;
        float a2[8], uu[8], e0[8], e1[8];
        unpack8(*(const u32x4*)(row + n), a2); unpack8(*(const u32x4*)(row + FF + n), uu);
        const int bs = srow >> 2, t = srow & 3;
        const float* sb = P.in[6] + ((size_t)(l * 128 + bs) * 2) * FF + n;
        if (t >= 1) unpack8(*(const u32x4*)(row - AUW + n), e1); else { const f32x4 x0 = *(const f32x4*)(sb + FF), x1 = *(const f32x4*)(sb + FF + 4);
            e1[0] = x0[0]; e1[1] = x0[1]; e1[2] = x0[2]; e1[3] = x0[3]; e1[4] = x1[0]; e1[5] = x1[1]; e1[6] = x1[2]; e1[7] = x1[3]; }
        if (t >= 2) unpack8(*(const u32x4*)(row - 2 * AUW + n), e0); else { const float* s2 = sb + (t == 0 ? 0 : FF); const f32x4 x0 = *(const f32x4*)s2, x1 = *(const f32x4*)(s2 + 4);
            e0[0] = x0[0]; e0[1] = x0[1]; e0[2] = x0[2]; e0[3] = x0[3]; e0[4] = x1[0]; e0[5] = x1[1]; e0[6] = x1[2]; e0[7] = x1[3]; }
        if (t >= 2) { float* o = P.out + O_CONVS + ((size_t)(l * 128 + bs) * 2 + (t - 2)) * FF + n;
            *(f32x4*)o = (f32x4){a2[0], a2[1], a2[2], a2[3]}; *(f32x4*)(o + 4) = (f32x4){a2[4], a2[5], a2[6], a2[7]}; }
        conv_item(e0, e1, a2, uu, wl, n, Gb + (size_t)(MP + srow) * FF + n);
    }
}

__device__ __forceinline__ void phase_final(CParams& P) {
    const int tid = get_tid(), wid = tid >> 6, lane = tid & 63;
    const int gw = get_bid() * 8 + wid, NGW = get_gdim() * 8;
    float* X = P.out; const bf16_t* XB = (const bf16_t*)(P.ws + WS_XB); const float* SS = (const float*)(P.ws + WS_SS); const float* gf = P.in[26];
    for (int row = gw; row < MTOK; row += NGW) {
        float s = lane < 16 ? SS[(size_t)lane * MTOK + row] : 0.f; s = wave_sum(s);
        const float rstd = rsqrtf(s * (1.f / 1024.f) + EPS);
#pragma unroll
        for (int j = 0; j < 4; ++j) { float* p = X + (size_t)row * 1024 + 4 * lane + 256 * j; const u32x2 xr = *(const u32x2*)(XB + (size_t)row * 1024 + 4 * lane + 256 * j);
            const f32x4 v = (f32x4){bflo(xr.x), bfhi(xr.x), bflo(xr.y), bfhi(xr.y)}, gg = *(const f32x4*)(gf + 4 * lane + 256 * j);
            *(f32x4*)p = v * rstd * gg; }
    }
}

__device__ __forceinline__ void small_resid_unit(const bf16_t* A, int lda, const bf16_t* Bt, int ldb, int K, int r0, int c0, bf16_t* XB, float* ss, LAS unsigned char* lds) {
    const int tid = get_tid(), wid = tid >> 6, lane = tid & 63, fr = lane & 15, fq = lane >> 4;
    LAS float* red = (LAS float*)lds;
    const int kw = K >> 3, k0 = wid * kw, nsteps = kw >> 5;
    const bf16_t* ap = A + (size_t)(r0 + fr) * lda + k0 + 8 * fq;
    const bf16_t* bp = Bt + (size_t)(c0 + fr) * ldb + k0 + 8 * fq;
    f32x4 acc[2][4];
#pragma unroll
    for (int mi = 0; mi < 2; ++mi)
#pragma unroll
        for (int ni = 0; ni < 4; ++ni) acc[mi][ni] = (f32x4){0.f, 0.f, 0.f, 0.f};
    bf16x8 a[2][2], b[2][4];
#pragma unroll
    for (int i = 0; i < 4; ++i) { if (i < 2) a[0][i] = *(const bf16x8*)(ap + (size_t)(16 * i) * lda); b[0][i] = *(const bf16x8*)(bp + (size_t)(16 * i) * ldb); }
#pragma unroll 1
    for (int st = 0; st < nsteps; st += 2) {
        if (st + 1 < nsteps) {
#pragma unroll
            for (int i = 0; i < 4; ++i) { if (i < 2) a[1][i] = *(const bf16x8*)(ap + (size_t)(16 * i) * lda + 32 * (st + 1)); b[1][i] = *(const bf16x8*)(bp + (size_t)(16 * i) * ldb + 32 * (st + 1)); } }
#pragma unroll
        for (int mi = 0; mi < 2; ++mi)
#pragma unroll
            for (int ni = 0; ni < 4; ++ni) acc[mi][ni] = __builtin_amdgcn_mfma_f32_16x16x32_bf16(a[0][mi], b[0][ni], acc[mi][ni], 0, 0, 0);
        if (st + 1 < nsteps) {
            if (st + 2 < nsteps) {
#pragma unroll
                for (int i = 0; i < 4; ++i) { if (i < 2) a[0][i] = *(const bf16x8*)(ap + (size_t)(16 * i) * lda + 32 * (st + 2)); b[0][i] = *(const bf16x8*)(bp + (size_t)(16 * i) * ldb + 32 * (st + 2)); } }
#pragma unroll
            for (int mi = 0; mi < 2; ++mi)
#pragma unroll
                for (int ni = 0; ni < 4; ++ni) acc[mi][ni] = __builtin_amdgcn_mfma_f32_16x16x32_bf16(a[1][mi], b[1][ni], acc[mi][ni], 0, 0, 0);
        }
    }
#pragma unroll
    for (int mi = 0; mi < 2; ++mi)
#pragma unroll
        for (int ni = 0; ni < 4; ++ni)
#pragma unroll
            for (int j = 0; j < 4; ++j) red[wid * 2048 + (16 * mi + 4 * fq + j) * 64 + 16 * ni + fr] = acc[mi][ni][j];
    __syncthreads();
    const int row = tid >> 4, cb = (tid & 15) * 4;
    const u32x2 xr = *(const u32x2*)(XB + (size_t)(r0 + row) * 1024 + c0 + cb);
    f32x4 v = (f32x4){bflo(xr.x), bfhi(xr.x), bflo(xr.y), bfhi(xr.y)};
#pragma unroll
    for (int w = 0; w < 8; ++w) v += *(LAS const f32x4*)(red + w * 2048 + row * 64 + cb);
    float sq = v[0] * v[0] + v[1] * v[1] + v[2] * v[2] + v[3] * v[3];
    u32x2 o; o.x = cvt_pk_bf16(v[0], v[1]); o.y = cvt_pk_bf16(v[2], v[3]); *(u32x2*)(XB + (size_t)(r0 + row) * 1024 + c0 + cb) = o;
    sq += __shfl_xor(sq, 1); sq += __shfl_xor(sq, 2); sq += __shfl_xor(sq, 4); sq += __shfl_xor(sq, 8);
    if ((tid & 15) == 0) ss[(size_t)(c0 >> 6) * MTOK + r0 + row] = sq;
    __syncthreads();
}

__device__ __forceinline__ void small_oddin_unit(const bf16_t* A, int lda, const bf16_t* Bt, int ldb, int K, int r0, int c0, const float* ss, bf16_t* U, bf16_t* V, float* lns, LAS unsigned char* lds) {
    const int tid = get_tid(), wid = tid >> 6, lane = tid & 63, fr = lane & 15, fq = lane >> 4;
    LAS float* red = (LAS float*)lds;
    const int kw = K >> 3, k0 = wid * kw, nsteps = kw >> 5;
    const bf16_t* ap = A + (size_t)(r0 + fr) * lda + k0 + 8 * fq;
    const bf16_t* bp = Bt + (size_t)(c0 + fr) * ldb + k0 + 8 * fq;
    f32x4 acc[4][4];
#pragma unroll
    for (int mi = 0; mi < 4; ++mi)
#pragma unroll
        for (int ni = 0; ni < 4; ++ni) acc[mi][ni] = (f32x4){0.f, 0.f, 0.f, 0.f};
    bf16x8 a[2][4], b[2][4];
#pragma unroll
    for (int i = 0; i < 4; ++i) { a[0][i] = *(const bf16x8*)(ap + (size_t)(16 * i) * lda); b[0][i] = *(const bf16x8*)(bp + (size_t)(16 * i) * ldb); }
#pragma unroll 1
    for (int st = 0; st < nsteps; st += 2) {
        if (st + 1 < nsteps) {
#pragma unroll
            for (int i = 0; i < 4; ++i) { a[1][i] = *(const bf16x8*)(ap + (size_t)(16 * i) * lda + 32 * (st + 1)); b[1][i] = *(const bf16x8*)(bp + (size_t)(16 * i) * ldb + 32 * (st + 1)); } }
#pragma unroll
        for (int mi = 0; mi < 4; ++mi)
#pragma unroll
            for (int ni = 0; ni < 4; ++ni) acc[mi][ni] = __builtin_amdgcn_mfma_f32_16x16x32_bf16(a[0][mi], b[0][ni], acc[mi][ni], 0, 0, 0);
        if (st + 1 < nsteps) {
            if (st + 2 < nsteps) {
#pragma unroll
                for (int i = 0; i < 4; ++i) { a[0][i] = *(const bf16x8*)(ap + (size_t)(16 * i) * lda + 32 * (st + 2)); b[0][i] = *(const bf16x8*)(bp + (size_t)(16 * i) * ldb + 32 * (st + 2)); } }
#pragma unroll
            for (int mi = 0; mi < 4; ++mi)
#pragma unroll
                for (int ni = 0; ni < 4; ++ni) acc[mi][ni] = __builtin_amdgcn_mfma_f32_16x16x32_bf16(a[1][mi], b[1][ni], acc[mi][ni], 0, 0, 0);
        }
    }
#pragma unroll
    for (int mi = 0; mi < 4; ++mi)
#pragma unroll
        for (int ni = 0; ni < 4; ++ni)
#pragma unroll
            for (int j = 0; j < 4; ++j) red[wid * 4096 + (16 * mi + 4 * fq + j) * 64 + 16 * ni + fr] = acc[mi][ni][j];
    __syncthreads();
    const int row = tid >> 3, cb = (tid & 7) * 8;
    float v[8];
#pragma unroll
    for (int q = 0; q < 8; ++q) v[q] = 0.f;
    float s2 = 0.f;
#pragma unroll
    for (int j = 0; j < 16; ++j) s2 += ss[(size_t)j * MTOK + r0 + row];
    const float rstd = rsqrtf(s2 * (1.f / 1024.f) + EPS);
#pragma unroll
    for (int w = 0; w < 8; ++w) { const f32x4 p0 = *(LAS const f32x4*)(red + w * 4096 + row * 64 + cb), p1 = *(LAS const f32x4*)(red + w * 4096 + row * 64 + cb + 4);
        v[0] += p0[0]; v[1] += p0[1]; v[2] += p0[2]; v[3] += p0[3]; v[4] += p1[0]; v[5] += p1[1]; v[6] += p1[2]; v[7] += p1[3]; }
    float sm = 0.f, sq = 0.f;
#pragma unroll
    for (int q = 0; q < 8; ++q) { v[q] = gelu_t(v[q] * rstd); sm += v[q]; sq += v[q] * v[q]; }
    const bool isv = c0 >= 1024;
    bf16_t* dst = isv ? V + (size_t)(r0 + row) * 1024 + (c0 - 1024) + cb : U + (size_t)(r0 + row) * 1024 + c0 + cb;
    *(u32x4*)dst = pack8(v);
    sm += __shfl_xor(sm, 1); sm += __shfl_xor(sm, 2); sm += __shfl_xor(sm, 4);
    sq += __shfl_xor(sq, 1); sq += __shfl_xor(sq, 2); sq += __shfl_xor(sq, 4);
    if (isv && (tid & 7) == 0) { const int slot = (c0 - 1024) >> 6; lns[(size_t)slot * MTOK + r0 + row] = sm; lns[(size_t)(16 + slot) * MTOK + r0 + row] = sq; }
    __syncthreads();
}

#define XB_TMO      128
#define XB_XCNT(j)  (256  + 64 * (j))
#define XB_XSUB(j)  (1280 + 64 * (j))
#define XB_XGEN(j)  (2304 + 64 * (j))
#define XB_TOP      3328
#define XB_TOPGEN   3392
#define XCD_BAR_WORDS 3456
#define XB_SPIN_CAP (1u << 18)
__device__ __forceinline__ unsigned xb_ld(unsigned* p)              { return __hip_atomic_load(p, __ATOMIC_RELAXED, __HIP_MEMORY_SCOPE_AGENT); }
__device__ __forceinline__ unsigned xb_add(unsigned* p, unsigned v) { return __hip_atomic_fetch_add(p, v, __ATOMIC_RELAXED, __HIP_MEMORY_SCOPE_AGENT); }
__device__ __forceinline__ unsigned xb_xcc_id() { return (unsigned)__builtin_amdgcn_s_getreg((3 << 11) | 20) & 0xFu; }
#define XB_SPIN(cond, bar) do { unsigned _sp = 0; while (cond) { __builtin_amdgcn_s_sleep(1); \
    if ((++_sp & 255u) == 0u) { if (xb_ld(&(bar)[XB_TMO])) break; if (_sp > XB_SPIN_CAP) { atomicAdd(&(bar)[XB_TMO], 1u); break; } } } } while (0)
struct XcdBarrier { unsigned* bar; unsigned x; volatile LAS unsigned* st; };
__device__ __forceinline__ XcdBarrier xcd_barrier_post(unsigned* bar, volatile LAS unsigned* st) {
    XcdBarrier b; b.bar = bar; b.x = xb_xcc_id(); b.st = st;
    if (threadIdx.x == 0) (void)xb_add(&bar[XB_XCNT(b.x)], 1u);
    return b;
}
__device__ __forceinline__ void xcd_barrier_complete(unsigned* bar, unsigned x, unsigned& nloc, unsigned& nx) {
    const unsigned G = gridDim.x * gridDim.y * gridDim.z;
    unsigned sum, cnt, mine, sp = 0u;
    for (;;) {
        sum = 0u; cnt = 0u; mine = 0u;
#pragma unroll
        for (unsigned j = 0; j < 16; ++j) { const unsigned c = xb_ld(&bar[XB_XCNT(j)]); sum += c; cnt += (c > 0u) ? 1u : 0u; mine = (j == x) ? c : mine; }
        if (sum == G) break;
        __builtin_amdgcn_s_sleep(1);
        if ((++sp & 255u) == 0u) { if (xb_ld(&bar[XB_TMO])) break; if (sp > XB_SPIN_CAP) { atomicAdd(&bar[XB_TMO], 1u); break; } }
    }
    nloc = mine > 0u ? mine : 1u; nx = cnt > 0u ? cnt : 1u;
}
__device__ __forceinline__ void xcd_barrier(const XcdBarrier& b) {
    asm volatile("s_waitcnt vmcnt(0)" ::: "memory");
    __syncthreads();
    if (threadIdx.x == 0) {
        unsigned* bar = b.bar;
        __builtin_amdgcn_s_waitcnt(0);
        unsigned nloc = b.st[0], nx = b.st[1];
        if (nloc == 0u) { xcd_barrier_complete(bar, b.x, nloc, nx); b.st[0] = nloc; b.st[1] = nx; }
        const unsigned old = xb_add(&bar[XB_XSUB(b.x)], 1u);
        const unsigned gen = old / nloc;
        if (old + 1u == (gen + 1u) * nloc) {
            __builtin_amdgcn_fence(__ATOMIC_RELEASE, "agent");
            asm volatile("s_waitcnt vmcnt(0)" ::: "memory");
            const unsigned og = xb_add(&bar[XB_TOP], 1u);
            const unsigned tg = og / nx;
            if (og + 1u == (tg + 1u) * nx) xb_add(&bar[XB_TOPGEN], 1u);
            else XB_SPIN(xb_ld(&bar[XB_TOPGEN]) == tg, bar);
            __builtin_amdgcn_fence(__ATOMIC_ACQUIRE, "agent");
            xb_add(&bar[XB_XGEN(b.x)], 1u);
            asm volatile("s_waitcnt vmcnt(0)" ::: "memory");
        } else {
            XB_SPIN(xb_ld(&bar[XB_XGEN(b.x)]) == gen, bar);
            __builtin_amdgcn_fence(__ATOMIC_ACQUIRE, "agent");
            asm volatile("s_waitcnt vmcnt(0)" ::: "memory");
        }
    }
    __syncthreads();
}

__global__ void __launch_bounds__(512) mega(const Params Pkarg, const int ph_lo, const int ph_hi) {
    extern __shared__ __attribute__((aligned(16))) unsigned char shm[];
    LAS unsigned char* lds = (LAS unsigned char*)shm;
    LAS float* rsbuf = (LAS float*)(lds + pg8::STAGE_BYTES);
    volatile LAS unsigned* xbst = (volatile LAS unsigned*)(lds + LDS_BYTES - 16);
    XcdBarrier xb; xb.bar = nullptr; xb.x = 0; xb.st = xbst;
    if (ph_hi - ph_lo > 1) {
        if (threadIdx.x == 0) { xbst[0] = 0u; xbst[1] = 0u; }
        __syncthreads();
        xb = xcd_barrier_post((unsigned*)(((CParams*)__builtin_amdgcn_kernarg_segment_ptr())->ws + WS_BAR), xbst);
    }
    for (int ph = ph_lo; ph < ph_hi; ++ph) {
        const int G = get_gdim(), bid = get_bid();
        CParams* Pp = (CParams*)__builtin_amdgcn_kernarg_segment_ptr();
        asm volatile("" : "+s"(Pp));
        CParams& P = *Pp;
        unsigned char* big = P.ws + WS_BIG;
        int kind, l = 0;
        if (ph == 0) kind = 0;
        else if (ph == NPHASE - 1) kind = 12;
        else { int q = ph - 1; if (q < 8) l = 0; else if (q < 14) { l = 1; q -= 8; } else if (q < 22) { l = 2; q -= 14; } else { l = 3; q -= 22; }
            const int nm = (l & 1) ? 3 : 5; kind = q < nm ? ((l & 1) ? 6 + q : 1 + q) : 9 + (q - nm); }
        const int e = l >> 1;
#ifdef DUP_KIND
        const int reps = (kind == DUP_KIND) ? 3 : 1;
#else
        const int reps = 1;
#endif
        for (int rep = 0; rep < reps; ++rep)
        switch (kind) {
#ifndef PMASK
#define PMASK 0xFFFF
#endif
#define PM(k) if (PMASK & (1 << (k)))
        case 0: PM(0) phase_prep(P, lds); break;
        case 1: PM(1) {
            pg8::Gemm g{(const bf16_t*)(P.ws + WS_XB), (const bf16_t*)(P.ws + WS_EIN) + (size_t)e * 2560 * 1024, MTOK, 2560, 1024, 1024, 1024};
            pg8::StaticOrder S; S.init(MTOK, 2560, G, bid); pg8::precompute_rstd(S, (const float*)(P.ws + WS_SS), rsbuf);
            pg8::EpiScaleBf16 E{(bf16_t*)(big + B_ZB), NZ, rsbuf};
            pg8::gemm_phase(lds, g, S, E);
            phase_gates(P, e, lds);
        } break;
        case 2: PM(2) {
            for (int j = 0; j * G < 512; ++j) { const int u = (j & 1) ? (j + 1) * G - 1 - bid : j * G + bid; if (u < 512) e2_unit(P, u, lds); }
            for (int u = bid; u < 528; u += G) pool_unit(P, e, u >> 2, u & 3, lds);
        } break;
        case 3: PM(3) {
            phase_scan(P, e, lds);
            for (int u = bid; u < 512; u += G) mlstm_sample_unit(P, e, u, lds);
        } break;
        case 4: PM(4) for (int u = bid; u < 512; u += G) e4_unit(P, e, u, lds); break;
        case 5: case 8: case 11: PM(5) {
            pg8::Gemm g;
            if (kind == 5) g = pg8::Gemm{(const bf16_t*)(big + B_YMIX), (const bf16_t*)(P.ws + WS_EOUT) + (size_t)e * 1024 * 1024, MTOK, 1024, 1024, 1024, 1024};
            else if (kind == 8) g = pg8::Gemm{(const bf16_t*)(big + B_US), (const bf16_t*)(P.ws + WS_OOUT) + (size_t)e * 1024 * 1024, MTOK, 1024, 1024, 1024, 1024};
            else g = pg8::Gemm{(const bf16_t*)(big + B_G), (const bf16_t*)(P.ws + WS_F2) + (size_t)l * 1024 * 2816, MTOK, 1024, FF, FF, FF};
            pg8::StaticOrder S; S.init(MP, 1024, G, bid);
            pg8::EpiResid E{(bf16_t*)(P.ws + WS_XB), (float*)(P.ws + WS_SS)};
            pg8::gemm_phase(lds, g, S, E);
            for (int u = bid; u < 256; u += G)
                small_resid_unit(g.A, g.lda, g.Bt, g.ldb, g.K, MP + (u >> 4) * 32, (u & 15) * 64, (bf16_t*)(P.ws + WS_XB), (float*)(P.ws + WS_SS), lds);
        } break;
        case 6: PM(6) {
            pg8::Gemm g{(const bf16_t*)(P.ws + WS_XB), (const bf16_t*)(P.ws + WS_OIN) + (size_t)e * 2048 * 1024, MTOK, 2048, 1024, 1024, 1024};
            pg8::StaticOrder S; S.init(MP, 2048, G, bid); pg8::precompute_rstd(S, (const float*)(P.ws + WS_SS), rsbuf);
            pg8::EpiOddIn E{(bf16_t*)(big + B_U), (bf16_t*)(big + B_VPRE), (float*)(big + B_LNS), rsbuf};
            pg8::gemm_phase(lds, g, S, E);
            for (int u = bid; u < 256; u += G)
                small_oddin_unit(g.A, g.lda, g.Bt, g.ldb, g.K, MP + (u >> 5) * 64, (u & 31) * 64, (const float*)(P.ws + WS_SS), (bf16_t*)(big + B_U), (bf16_t*)(big + B_VPRE), (float*)(big + B_LNS), lds);
        } break;
        case 7: PM(7) {
            for (int u = bid; u < 512; u += G) sgu_unit(P, e, u, lds);
            sgu_sample(P, e);
        } break;
        case 9: PM(9) {
            pg8::Gemm g{(const bf16_t*)(P.ws + WS_XB), (const bf16_t*)(P.ws + WS_F1) + (size_t)l * 5632 * 1024, MTOK, 5632, 1024, 1024, 1024};
            pg8::StaticOrder S; S.init(MTOK, 5632, G, bid); pg8::precompute_rstd(S, (const float*)(P.ws + WS_SS), rsbuf);
            pg8::EpiFfn E{(bf16_t*)(big + B_G), (bf16_t*)(big + B_AUS), (float*)(big + B_HF), (float*)(big + B_HU), (float*)(big + B_HL), rsbuf, P.in[23] + (size_t)l * 3 * FF, P.in[24] + (size_t)l * FF};
            pg8::gemm_phase(lds, g, S, E);
        } break;
        case 10: PM(10) phase_conv(P, l, lds); break;
        case 12: PM(12) phase_final(P); break;
        }
#if USE_CG_SYNC
        if (ph + 1 < ph_hi) cg::this_grid().sync();
#else
        if (ph + 1 < ph_hi) { if (ph_lo < 0) cg::this_grid().sync(); else xcd_barrier(xb); }
#endif
    }
}

static void add_job(Params& p, int& nj, int& items, const float* W, bf16_t* WT, const float* gk, int K, int ldw, int ncols, int ldt, int n_lo, int n_hi, float nscale) {
    TJob& j = p.jobs[nj++]; j.W = W; j.WT = WT; j.gk = gk; j.K = K; j.ldw = ldw; j.ncols = ncols; j.ldt = ldt; j.n_lo = n_lo; j.n_hi = n_hi; j.nscale = nscale; j.item0 = items; j.rmode = 0; j.roff = 0;
    items += (K / 64) * (ncols / 32);
}

extern "C" void kernel_launch(void* const* d_in, const int* in_sizes, int n_in, void* d_out, int out_size, void* d_ws, size_t ws_size, hipStream_t stream) {
    static int grid = 0;
    if (grid == 0) {
        if (n_in != 27 || ws_size < WS_END) { fprintf(stderr, "kernel_launch: need 27 inputs and %zu bytes of workspace (got %d, %zu)\n", (size_t)WS_END, n_in, ws_size); grid = -1; return; }
        int dev = 0, cus = 0, per_cu = 0;
        (void)hipGetDevice(&dev); (void)hipDeviceGetAttribute(&cus, hipDeviceAttributeMultiprocessorCount, dev);
        if (hipFuncSetAttribute((const void*)mega, hipFuncAttributeMaxDynamicSharedMemorySize, LDS_BYTES) != hipSuccess) { fprintf(stderr, "hipFuncSetAttribute failed\n"); grid = -1; return; }
        (void)hipOccupancyMaxActiveBlocksPerMultiprocessor(&per_cu, (const void*)mega, 512, LDS_BYTES);
        if (per_cu < 1) per_cu = 1;
        (void)hipGetLastError();
        grid = cus * 1;
    }
    if (grid < 0) return;
    Params p; memset(&p, 0, sizeof(p));
    for (int i = 0; i < 27; ++i) p.in[i] = (const float*)d_in[i];
    p.out = (float*)d_out; p.ws = (unsigned char*)d_ws;
    unsigned char* ws = (unsigned char*)d_ws;
    int nj = 0, items = 0;
    const float kq = 0.08838834764831845f;
    for (int e = 0; e < 2; ++e) add_job(p, nj, items, p.in[8] + (size_t)e * 1024 * 2568, (bf16_t*)(ws + WS_EIN) + (size_t)e * 2560 * 1024, p.in[7] + (2 * e) * 1024, 1024, 2568, 2560, 1024, 1024, 1536, kq);
    for (int e = 0; e < 2; ++e) add_job(p, nj, items, p.in[13] + (size_t)e * 1024 * 1024, (bf16_t*)(ws + WS_EOUT) + (size_t)e * 1024 * 1024, nullptr, 1024, 1024, 1024, 1024, 0, 0, 1.f);
    for (int o = 0; o < 2; ++o) add_job(p, nj, items, p.in[14] + (size_t)o * 1024 * 2048, (bf16_t*)(ws + WS_OIN) + (size_t)o * 2048 * 1024, p.in[7] + (2 * o + 1) * 1024, 1024, 2048, 2048, 1024, 0, 0, 1.f);
    for (int o = 0; o < 2; ++o) add_job(p, nj, items, p.in[19] + (size_t)o * 1024 * 1024, (bf16_t*)(ws + WS_OOUT) + (size_t)o * 1024 * 1024, nullptr, 1024, 1024, 1024, 1024, 0, 0, 1.f);
    for (int l = 0; l < 4; ++l) {
        add_job(p, nj, items, p.in[21] + (size_t)l * 1024 * FF, (bf16_t*)(ws + WS_F1) + (size_t)l * 5632 * 1024, p.in[20] + l * 1024, 1024, FF, FF, 1024, 0, 0, 1.f);
        p.jobs[nj - 1].rmode = 1; p.jobs[nj - 1].roff = 0;
        add_job(p, nj, items, p.in[22] + (size_t)l * 1024 * FF, (bf16_t*)(ws + WS_F1) + (size_t)l * 5632 * 1024, p.in[20] + l * 1024, 1024, FF, FF, 1024, 0, 0, 1.f);
        p.jobs[nj - 1].rmode = 1; p.jobs[nj - 1].roff = 128;
    }
    for (int l = 0; l < 4; ++l) add_job(p, nj, items, p.in[25] + (size_t)l * FF * 1024, (bf16_t*)(ws + WS_F2) + (size_t)l * 1024 * FF, nullptr, FF, 1024, 1024, FF, 0, 0, 1.f);
    p.nitems = items;
#ifndef RUN_HI
#define RUN_HI NPHASE
#endif
#if ONE_LAUNCH
    (void)hipMemsetAsync((unsigned char*)d_ws + WS_BAR, 0, 16384, stream);
    int lo = 0, hi = RUN_HI;
    void* args[] = {(void*)&p, (void*)&lo, (void*)&hi};
    hipError_t err = hipLaunchCooperativeKernel((const void*)mega, dim3(grid), dim3(512), args, LDS_BYTES, stream);
    if (err != hipSuccess) fprintf(stderr, "cooperative launch failed: %s (grid %d)\n", hipGetErrorString(err), grid);
#else
    for (int ph = 0; ph < RUN_HI; ++ph) hipLaunchKernelGGL(mega, dim3(grid), dim3(512), LDS_BYTES, stream, p, ph, ph + 1);
#endif
}
```

```cpp
#include <hip/hip_runtime.h>
#include <hip/hip_cooperative_groups.h>
#include <cstdio>
#include <cstring>
namespace cg = cooperative_groups;

#define LAS __attribute__((address_space(3)))
typedef unsigned short bf16_t;
typedef short bf16x8 __attribute__((ext_vector_type(8)));
typedef float f32x4 __attribute__((ext_vector_type(4)));
typedef unsigned u32x4 __attribute__((ext_vector_type(4)));
typedef unsigned u32x2 __attribute__((ext_vector_type(2)));

#ifndef USE_CG_SYNC
#define USE_CG_SYNC 0
#endif
#ifndef ONE_LAUNCH
#define ONE_LAUNCH 1

#endif

constexpr int MTOK = 16896, MP = 16384, DM = 1024, NZ = 2560, FF = 2816, AUW = 5632;
constexpr float EPS = 1e-6f;
constexpr int NPHASE = 30;
constexpr int LDS_BYTES = 147456;

constexpr size_t O_POOLP = 17301504, O_POOLS = 17424384, O_CP = 19390464, O_CS = 20439040, O_NP = 37216256, O_NS = 37224448,
                 O_MP = 37355520, O_MS = 37355584, O_CONVP = 37356608, O_CONVS = 37536832, O_V = 40420416;

constexpr size_t WS_EIN = 0;
constexpr size_t WS_EOUT = WS_EIN + 2ull * 2560 * 1024 * 2;
constexpr size_t WS_OIN = WS_EOUT + 2ull * 1024 * 1024 * 2;
constexpr size_t WS_OOUT = WS_OIN + 2ull * 2048 * 1024 * 2;
constexpr size_t WS_F1 = WS_OOUT + 2ull * 1024 * 1024 * 2;
constexpr size_t WS_F2 = WS_F1 + 4ull * 5632 * 1024 * 2;
constexpr size_t WS_WG = WS_F2 + 4ull * 1024 * 2816 * 2;
constexpr size_t WS_WPOOL = WS_WG + 2ull * 8 * 1024 * 4;
constexpr size_t WS_WSP = WS_WPOOL + 2ull * 4 * 128 * 128 * 2;
constexpr size_t WS_XB = WS_WSP + 2ull * 4 * 128 * 128 * 2;
constexpr size_t WS_SS = WS_XB + (size_t)MTOK * 1024 * 2;
constexpr size_t WS_BIG = WS_SS + 16ull * MTOK * 4;
constexpr size_t WS_BAR = WS_BIG + (size_t)MTOK * AUW * 2;
constexpr size_t WS_WGB = WS_BAR + 16384;
constexpr size_t WS_END = WS_WGB + 2ull * 16 * 1024 * 2;
constexpr size_t B_ZB = 0;
constexpr size_t B_GATES = B_ZB + (size_t)MTOK * NZ * 2;
constexpr size_t B_BT = B_GATES + (size_t)MTOK * 8 * 4;
constexpr size_t B_SCAL = B_BT + (size_t)MP * 4 * 4;
constexpr size_t B_DC = B_SCAL + 512 * 4 * 4;
constexpr size_t B_DN = B_DC + 512ull * 16384 * 4;
constexpr size_t B_CPREV = B_DN + 512ull * 128 * 4;
constexpr size_t B_NPREV = B_CPREV + 512ull * 16384 * 2;
constexpr size_t B_YMIX = B_NPREV + 512ull * 128 * 4;
constexpr size_t B_EVEN_END = B_YMIX + (size_t)MTOK * 1024 * 2;
static_assert(B_EVEN_END <= (size_t)MTOK * AUW * 2, "even scratch too big");
constexpr size_t B_G = 0;
constexpr size_t B_AUS = B_G + (size_t)MTOK * FF * 2;
constexpr size_t B_HF = B_AUS + 512ull * AUW * 2;
constexpr size_t B_HU = B_HF + 256ull * 2 * FF * 4;
constexpr size_t B_HL = B_HU + 256ull * 2 * FF * 4;
constexpr size_t B_U = 0;
constexpr size_t B_VPRE = B_U + (size_t)MTOK * 1024 * 2;
constexpr size_t B_LNS = B_VPRE + (size_t)MTOK * 1024 * 2;
constexpr size_t B_US = B_LNS + 2ull * 16 * MTOK * 4;

struct TJob { const float* W; bf16_t* WT; const float* gk; int K, ldw, ncols, ldt, n_lo, n_hi; float nscale; int item0; int rmode, roff; };
constexpr int NJOBS = 20;
struct Params {
    const float* in[27];
    float* out;
    unsigned char* ws;
    TJob jobs[NJOBS];
    int nitems; int pad;
};

typedef const __attribute__((address_space(4))) Params CParams;
typedef const __attribute__((address_space(4))) TJob CTJob;

__device__ __forceinline__ unsigned cvt_pk_bf16(float lo, float hi) { unsigned r; asm volatile("v_cvt_pk_bf16_f32 %0, %1, %2" : "=v"(r) : "v"(lo), "v"(hi)); return r; }
__device__ __forceinline__ bf16_t f2bf(float f) { return (bf16_t)(cvt_pk_bf16(f, 0.f) & 0xffffu); }
__device__ __forceinline__ float bf2f(bf16_t b) { return __uint_as_float(((unsigned)b) << 16); }
__device__ __forceinline__ float bflo(unsigned u) { return __uint_as_float(u << 16); }
__device__ __forceinline__ float bfhi(unsigned u) { return __uint_as_float(u & 0xffff0000u); }
__device__ __forceinline__ float wave_sum(float v) {
#pragma unroll
    for (int o = 1; o < 64; o <<= 1) v += __shfl_xor(v, o);
    return v;
}
__device__ __forceinline__ float wave_max(float v) {
#pragma unroll
    for (int o = 1; o < 64; o <<= 1) v = fmaxf(v, __shfl_xor(v, o));
    return v;
}
__device__ __forceinline__ float gelu_t(float x) {
    const float x2 = x * x;
    const float t = x * __builtin_fmaf(x2, -0.10294324f, -2.3022082f);
    return x * __builtin_amdgcn_rcpf(1.f + __builtin_amdgcn_exp2f(t));
}
typedef float f32x2 __attribute__((ext_vector_type(2)));
__device__ __forceinline__ f32x2 gelu_t2(f32x2 v) {
    const f32x2 x2 = v * v;
    const f32x2 t = v * (x2 * (-0.10294324f) + (-2.3022082f));
    f32x2 e; e.x = __builtin_amdgcn_exp2f(t.x); e.y = __builtin_amdgcn_exp2f(t.y);
    const f32x2 d = e + 1.0f;
    f32x2 r; r.x = __builtin_amdgcn_rcpf(d.x); r.y = __builtin_amdgcn_rcpf(d.y);
    return v * r;
}
__device__ __forceinline__ float sigmoidf_(float x) { return __builtin_amdgcn_rcpf(1.f + __expf(-x)); }
__device__ __forceinline__ void unpack8(const u32x4 v, float (&f)[8]) {
    f[0] = bflo(v.x); f[1] = bfhi(v.x); f[2] = bflo(v.y); f[3] = bfhi(v.y); f[4] = bflo(v.z); f[5] = bfhi(v.z); f[6] = bflo(v.w); f[7] = bfhi(v.w);
}
__device__ __forceinline__ u32x4 pack8(const float (&f)[8]) {
    u32x4 o; o.x = cvt_pk_bf16(f[0], f[1]); o.y = cvt_pk_bf16(f[2], f[3]); o.z = cvt_pk_bf16(f[4], f[5]); o.w = cvt_pk_bf16(f[6], f[7]); return o;
}
__device__ __forceinline__ int get_tid() { int t = threadIdx.x; asm volatile("" : "+v"(t)); return t; }
__device__ __forceinline__ int get_bid() { int t = blockIdx.x; asm volatile("" : "+s"(t)); return t; }
__device__ __forceinline__ int get_gdim() { int t = gridDim.x; asm volatile("" : "+s"(t)); return t; }
#define LDS_WAIT() asm volatile("s_waitcnt lgkmcnt(0)" ::: "memory")

namespace pg8 {
constexpr int BM = 256, BK = 64, HALF = 128, HTB = HALF * BK * 2, STAGE_BYTES = 8 * HTB, NXCD = 8, WGM = 8;
__device__ __forceinline__ int lds_byte(int r, int c) { const int st = (r >> 4) * 2 + (c >> 5), rr = r & 15, cc = c & 31, ob = rr * 64 + cc * 2; return st * 1024 + (ob ^ (((ob >> 9) & 1) << 5)); }
__device__ __forceinline__ void stage_rc(int b, int& R, int& C) { const int st = b / 1024, sb = b % 1024, swz = sb ^ (((sb >> 9) & 1) << 5); R = (st >> 1) * 16 + swz / 64; C = (st & 1) * 32 + (swz % 64) / 2; }
__device__ __forceinline__ int perm32(int rho) { const int n = rho >> 4, i = rho & 15; return 8 * (i >> 2) + 4 * n + (i & 3); }
struct Unit { int pm, pn; };
struct Gemm { const bf16_t* A; const bf16_t* Bt; int M, N, K, lda, ldb; };
struct StaticOrder {
    int nM, nN, nwg, G, c;
    __device__ void init(int M, int N, int G_, int c_) { nM = M / BM; nN = N / BM; nwg = nM * nN; G = G_; c = c_; }
    __device__ bool next(int i, Unit& u) const {
        const long L = (long)i * G + c; if (L >= nwg) return false;
        int wgid = (int)L; { const int q = nwg / NXCD, r = nwg % NXCD, xcd = wgid % NXCD, off = wgid / NXCD; wgid = (xcd < r ? xcd * (q + 1) : r * (q + 1) + (xcd - r) * q) + off; }
        const int nig = WGM * nN, gid = wgid / nig, fm = gid * WGM, gsz = (nM - fm) < WGM ? (nM - fm) : WGM;
        u.pm = fm + ((wgid % nig) % gsz); u.pn = (wgid % nig) / gsz; return true;
    }
    __device__ __forceinline__ void a_ready(const Unit&, int) const {}
};
__device__ __forceinline__ void precompute_rstd(const StaticOrder& S, const float* ss, LAS float* rs) {
    const int tid = get_tid(), half = tid >> 8, row = tid & 255;
    float sum[3]; bool ok[3];
#pragma unroll
    for (int k = 0; k < 3; ++k) { Unit u; ok[k] = S.next(half + 2 * k, u); sum[k] = 0.f;
        if (ok[k]) { const int r = u.pm * BM + row;
#pragma unroll
            for (int j = 0; j < 16; ++j) sum[k] += ss[(size_t)j * MTOK + r]; } }
#pragma unroll
    for (int k = 0; k < 3; ++k) if (ok[k]) rs[(half + 2 * k) * 256 + row] = rsqrtf(sum[k] * (1.f / 1024.f) + EPS);
    __syncthreads();
}

template <class Epi, class Sched>
__device__ __forceinline__ void gemm_phase(LAS unsigned char* lds, const Gemm g, const Sched& S, const Epi& E) {
    const int tid = get_tid(), wid = __builtin_amdgcn_readfirstlane(tid >> 6), lane = tid & 63, wr = wid >> 2, wc = wid & 3, fr = lane & 15, fq = lane >> 4;
    const int K = g.K, nt = K / BK;
    unsigned voffA, voffB;
    { int R, C; stage_rc(tid * 16, R, C);
      const int Rb = (R & ~31) + perm32(R & 31);
      voffA = (unsigned)(R * g.lda + C) * 2u; voffB = (unsigned)(Rb * g.ldb + C) * 2u; }
    const size_t dstepA = (size_t)64 * g.lda * 2, dstepB = (size_t)64 * g.ldb * 2;
    const size_t kstep = (size_t)(BK * 2);
    const size_t hstepA = (size_t)HALF * g.lda * 2, hstepB = (size_t)HALF * g.ldb * 2;
    const size_t tstepA = 2 * hstepA, tstepB = 2 * hstepB;
    const unsigned ldsw = (unsigned)wid * 1024u;
    const int aoff = lds_byte(wr * 64 + fr, fq * 8), boff = lds_byte(wc * 32 + fr, fq * 8);
#define PG8_SA(b, h) (((b) * 2 + (h)) * HTB)
#define PG8_SB(b, h) ((4 + (b) * 2 + (h)) * HTB)
#define PG8_STAGE(bufoff, gbase, voff) do { _Pragma("unroll") for (int _i = 0; _i < 2; ++_i) \
        __builtin_amdgcn_global_load_lds((const unsigned*)((const char*)(gbase) + (size_t)_i * d##voff + (voff)), (LAS unsigned*)(lds + (bufoff) + ldsw + _i * 8192), 16, 0, 0); } while (0)
#define dvoffA dstepA
#define dvoffB dstepB
#define PG8_LDA(dst, b, h) do { _Pragma("unroll") for (int m = 0; m < 4; ++m) _Pragma("unroll") for (int k = 0; k < 2; ++k) dst[m][k] = *(const LAS bf16x8*)(lds + PG8_SA(b, h) + aoff + m * 2048 + k * 1024); } while (0)
#define PG8_LDB(dst, b, h) do { _Pragma("unroll") for (int n = 0; n < 2; ++n) _Pragma("unroll") for (int k = 0; k < 2; ++k) dst[n][k] = *(const LAS bf16x8*)(lds + PG8_SB(b, h) + boff + n * 2048 + k * 1024); } while (0)
#define PG8_MMA(ai, bj, At, Bt) do { __builtin_amdgcn_s_setprio(1); _Pragma("unroll") for (int m = 0; m < 4; ++m) _Pragma("unroll") for (int n = 0; n < 2; ++n) _Pragma("unroll") for (int k = 0; k < 2; ++k) \
        acc[ai][bj][m][n] = __builtin_amdgcn_mfma_f32_16x16x32_bf16(Bt[n][k], At[m][k], acc[ai][bj][m][n], 0, 0, 0); __builtin_amdgcn_s_setprio(0); } while (0)
#define PG8_WAIT_V(n) asm volatile("s_waitcnt vmcnt(" #n ")" ::: "memory")
#define PG8_WAIT_L(n) asm volatile("s_waitcnt lgkmcnt(" #n ")" ::: "memory")
#define PG8_BAR __builtin_amdgcn_s_barrier()
#define PG8_SCHED __builtin_amdgcn_sched_barrier(0)
    Unit cur, nxt; int ui = 0;
    if (!S.next(0, cur)) return;
    f32x4 acc[2][2][4][2];
#pragma unroll
    for (int a = 0; a < 2; ++a)
#pragma unroll
        for (int b = 0; b < 2; ++b)
#pragma unroll
            for (int m = 0; m < 4; ++m)
#pragma unroll
                for (int n = 0; n < 2; ++n) acc[a][b][m][n] = (f32x4){0.f, 0.f, 0.f, 0.f};
    bf16x8 At[4][2], B0[2][2], B1[2][2];
    const char* cA = (const char*)g.A + (size_t)cur.pm * tstepA; const char* cB = (const char*)g.Bt + (size_t)cur.pn * tstepB;
    S.a_ready(cur, 0);
    PG8_STAGE(PG8_SB(0, 0), cB, voffB); PG8_STAGE(PG8_SA(0, 0), cA, voffA); PG8_STAGE(PG8_SB(0, 1), cB + hstepB, voffB); PG8_STAGE(PG8_SA(0, 1), cA + hstepA, voffA);
    if (wr == 1) PG8_BAR;
    PG8_WAIT_V(4); PG8_BAR;
    PG8_STAGE(PG8_SB(1, 0), cB + kstep, voffB); PG8_STAGE(PG8_SA(1, 0), cA + kstep, voffA); PG8_STAGE(PG8_SB(1, 1), cB + hstepB + kstep, voffB);
    PG8_WAIT_V(6); PG8_BAR;
    for (;;) {
        const bool has_next = S.next(ui + 1, nxt);
        const char* nA = has_next ? (const char*)g.A + (size_t)nxt.pm * tstepA : cA; const char* nB = has_next ? (const char*)g.Bt + (size_t)nxt.pn * tstepB : cB;
        for (int t = 0; t < nt; t += 2) {
            const bool last = (t == nt - 2);
            const char* a1 = cA + (size_t)(t + 1) * kstep;
            const char* a2 = last ? nA : cA + (size_t)(t + 2) * kstep; const char* b2 = last ? nB : cB + (size_t)(t + 2) * kstep;
            const char* a3 = a2 + kstep; const char* b3 = b2 + kstep;
            if (last && has_next) S.a_ready(nxt, ui + 1);
            PG8_LDB(B0, 0, 0); PG8_SCHED; PG8_LDA(At, 0, 0); PG8_STAGE(PG8_SA(1, 1), a1 + hstepA, voffA);
            PG8_WAIT_L(8); PG8_BAR; PG8_WAIT_L(0); PG8_MMA(0, 0, At, B0); PG8_BAR; PG8_SCHED;
            PG8_LDB(B1, 0, 1); PG8_STAGE(PG8_SB(0, 0), b2, voffB);
            PG8_BAR; PG8_WAIT_L(0); PG8_MMA(0, 1, At, B1); PG8_BAR;
            PG8_LDA(At, 0, 1); PG8_STAGE(PG8_SA(0, 0), a2, voffA);
            PG8_BAR; PG8_WAIT_L(0); PG8_MMA(1, 0, At, B0); PG8_BAR; PG8_SCHED;
            PG8_STAGE(PG8_SB(0, 1), b2 + hstepB, voffB);
            PG8_WAIT_V(6); PG8_BAR; PG8_MMA(1, 1, At, B1); PG8_BAR;
            PG8_LDB(B0, 1, 0); PG8_SCHED; PG8_LDA(At, 1, 0); PG8_STAGE(PG8_SA(0, 1), a2 + hstepA, voffA);
            PG8_WAIT_L(8); PG8_BAR; PG8_WAIT_L(0); PG8_MMA(0, 0, At, B0); PG8_BAR; PG8_SCHED;
            PG8_LDB(B1, 1, 1); PG8_STAGE(PG8_SB(1, 0), b3, voffB);
            PG8_BAR; PG8_WAIT_L(0); PG8_MMA(0, 1, At, B1); PG8_BAR;
            PG8_LDA(At, 1, 1); PG8_STAGE(PG8_SA(1, 0), a3, voffA);
            PG8_BAR; PG8_WAIT_L(0); PG8_MMA(1, 0, At, B0); PG8_BAR; PG8_SCHED;
            PG8_STAGE(PG8_SB(1, 1), b3 + hstepB, voffB);
            PG8_WAIT_V(6); PG8_BAR; PG8_MMA(1, 1, At, B1); PG8_BAR;
        }
        E(acc, cur, ui, wr, wc, fr, fq);
        if (!has_next) break;
#pragma unroll
        for (int a = 0; a < 2; ++a)
#pragma unroll
            for (int b = 0; b < 2; ++b)
#pragma unroll
                for (int m = 0; m < 4; ++m)
#pragma unroll
                    for (int n = 0; n < 2; ++n) acc[a][b][m][n] = (f32x4){0.f, 0.f, 0.f, 0.f};
        cur = nxt; cA = nA; cB = nB; ++ui;
    }
    PG8_WAIT_V(0);
    if (wr == 0) PG8_BAR;
    PG8_BAR;
#undef PG8_SA
#undef PG8_SB
#undef PG8_STAGE
#undef dvoffA
#undef dvoffB
#undef PG8_LDA
#undef PG8_LDB
#undef PG8_MMA
#undef PG8_WAIT_V
#undef PG8_WAIT_L
#undef PG8_BAR
#undef PG8_SCHED
}

struct EpiScaleBf16 {
    bf16_t* O; int ldc; LAS const float* rs;
    __device__ __forceinline__ void operator()(const f32x4 (&acc)[2][2][4][2], const Unit& u, int ui, int wr, int wc, int fr, int fq) const {
        LAS const float* r = rs + ui * 256;
#pragma unroll
        for (int ai = 0; ai < 2; ++ai)
#pragma unroll
            for (int m = 0; m < 4; ++m) {
                const int rl = ai * HALF + wr * 64 + m * 16 + fr; const float s = r[rl];
                bf16_t* rowp = O + (size_t)(u.pm * BM + rl) * ldc + u.pn * BM + wc * 32 + 8 * fq;
#pragma unroll
                for (int bj = 0; bj < 2; ++bj) { const f32x4 v0 = acc[ai][bj][m][0] * s, v1 = acc[ai][bj][m][1] * s;
                    u32x4 o; o.x = cvt_pk_bf16(v0[0], v0[1]); o.y = cvt_pk_bf16(v0[2], v0[3]); o.z = cvt_pk_bf16(v1[0], v1[1]); o.w = cvt_pk_bf16(v1[2], v1[3]);
                    *(u32x4*)(rowp + bj * HALF) = o; }
            }
    }
};
struct EpiOddIn {
    bf16_t* U; bf16_t* V; float* lns; LAS const float* rs;
    __device__ __forceinline__ void operator()(const f32x4 (&acc)[2][2][4][2], const Unit& u, int ui, int wr, int wc, int fr, int fq) const {
        LAS const float* r = rs + ui * 256;
        const bool isv = u.pn >= 4; bf16_t* O = isv ? V : U; const int pnl = isv ? u.pn - 4 : u.pn;
#pragma unroll
        for (int ai = 0; ai < 2; ++ai)
#pragma unroll
            for (int m = 0; m < 4; ++m) {
                const int rl = ai * HALF + wr * 64 + m * 16 + fr; const float s = r[rl]; const int row = u.pm * BM + rl;
                bf16_t* rowp = O + (size_t)row * 1024 + pnl * BM + wc * 32 + 8 * fq;
                float sm = 0.f, sq = 0.f;
#pragma unroll
                for (int bj = 0; bj < 2; ++bj) { unsigned pk[4];
#pragma unroll
                    for (int n = 0; n < 2; ++n) { f32x4 v = acc[ai][bj][m][n] * s;
                        { const f32x2 g0 = gelu_t2((f32x2){v[0], v[1]}), g1 = gelu_t2((f32x2){v[2], v[3]}); v[0] = g0.x; v[1] = g0.y; v[2] = g1.x; v[3] = g1.y; }
#pragma unroll
                        for (int j = 0; j < 4; ++j) { sm += v[j]; sq += v[j] * v[j]; }
                        pk[2 * n] = cvt_pk_bf16(v[0], v[1]); pk[2 * n + 1] = cvt_pk_bf16(v[2], v[3]); }
                    *(u32x4*)(rowp + bj * HALF) = (u32x4){pk[0], pk[1], pk[2], pk[3]}; }
                if (isv) {
                    sm += __shfl_xor(sm, 16); sm += __shfl_xor(sm, 32); sq += __shfl_xor(sq, 16); sq += __shfl_xor(sq, 32);
                    if (fq == 0) { const int slot = pnl * 4 + wc; lns[(size_t)slot * MTOK + row] = sm; lns[(size_t)(16 + slot) * MTOK + row] = sq; }
                }
            }
    }
};
__device__ __forceinline__ float dpp_ror1(float x) { return __int_as_float(__builtin_amdgcn_update_dpp(0, __float_as_int(x), 0x121, 0xf, 0xf, false)); }
__device__ __forceinline__ float dpp_ror2(float x) { return __int_as_float(__builtin_amdgcn_update_dpp(0, __float_as_int(x), 0x122, 0xf, 0xf, false)); }
__device__ __forceinline__ float dpp_shr1(float oldv, float x) { return __int_as_float(__builtin_amdgcn_update_dpp(__float_as_int(oldv), __float_as_int(x), 0x111, 0xf, 0xf, false)); }
__device__ __forceinline__ float dpp_shr2(float oldv, float x) { return __int_as_float(__builtin_amdgcn_update_dpp(__float_as_int(oldv), __float_as_int(x), 0x112, 0xf, 0xf, false)); }
struct EpiFfn {
    bf16_t* Gb; bf16_t* AUS; float* HF; float* HU; float* HL; LAS const float* rs; const float* cw; const float* cb;
    __device__ __forceinline__ void operator()(const f32x4 (&acc)[2][2][4][2], const Unit& u, int ui, int wr, int wc, int fr, int fq) const {
        LAS const float* r = rs + ui * 256;
        const int c0 = u.pn * 128 + wc * 32 + 8 * fq;
        if (u.pm >= 64) {
#pragma unroll
            for (int ai = 0; ai < 2; ++ai)
#pragma unroll
                for (int m = 0; m < 4; ++m) { const int rl = ai * HALF + wr * 64 + m * 16 + fr; const float sc = r[rl]; bf16_t* rowp = AUS + (size_t)((u.pm - 64) * BM + rl) * AUW + c0;
#pragma unroll
                    for (int bj = 0; bj < 2; ++bj) { const f32x4 v0 = acc[ai][bj][m][0] * sc, v1 = acc[ai][bj][m][1] * sc;
                        u32x4 o; o.x = cvt_pk_bf16(v0[0], v0[1]); o.y = cvt_pk_bf16(v0[2], v0[3]); o.z = cvt_pk_bf16(v1[0], v1[1]); o.w = cvt_pk_bf16(v1[2], v1[3]); *(u32x4*)(rowp + bj * FF) = o; } }
            return;
        }
        f32x4 w0[2], w1[2], w2[2], cbv[2];
#pragma unroll
        for (int n = 0; n < 2; ++n) { w0[n] = *(const f32x4*)(cw + c0 + 4 * n); w1[n] = *(const f32x4*)(cw + FF + c0 + 4 * n); w2[n] = *(const f32x4*)(cw + 2 * FF + c0 + 4 * n); cbv[n] = *(const f32x4*)(cb + c0 + 4 * n); }
#pragma unroll
        for (int ai = 0; ai < 2; ++ai) {
            const int rb = u.pm * 4 + ai * 2 + wr;
            f32x4 ap[2] = {(f32x4){0.f, 0.f, 0.f, 0.f}, (f32x4){0.f, 0.f, 0.f, 0.f}};
#pragma unroll
            for (int m = 0; m < 4; ++m) {
                const int rl = ai * HALF + wr * 64 + m * 16 + fr; const float sc = r[rl]; const size_t row = (size_t)u.pm * BM + rl;
                f32x4 a[2], uu[2];
#pragma unroll
                for (int n = 0; n < 2; ++n) { a[n] = acc[ai][0][m][n] * sc; uu[n] = acc[ai][1][m][n] * sc; }
                if (m == 0 && fr < 2) {
#pragma unroll
                    for (int n = 0; n < 2; ++n) { *(f32x4*)(HF + ((size_t)rb * 2 + fr) * FF + c0 + 4 * n) = a[n]; *(f32x4*)(HU + ((size_t)rb * 2 + fr) * FF + c0 + 4 * n) = uu[n]; } }
                if (m == 3 && fr >= 14) {
#pragma unroll
                    for (int n = 0; n < 2; ++n) *(f32x4*)(HL + ((size_t)rb * 2 + (fr - 14)) * FF + c0 + 4 * n) = a[n]; }
                unsigned gpk[4];
#pragma unroll
                for (int n = 0; n < 2; ++n) { f32x4 g;
#pragma unroll
                    for (int jp = 0; jp < 2; ++jp) {
                        const f32x2 cur = (f32x2){a[n][2 * jp], a[n][2 * jp + 1]}, pv = (f32x2){ap[n][2 * jp], ap[n][2 * jp + 1]};
                        f32x2 p1, p2; p1.x = dpp_shr1(dpp_ror1(pv.x), cur.x); p1.y = dpp_shr1(dpp_ror1(pv.y), cur.y); p2.x = dpp_shr2(dpp_ror2(pv.x), cur.x); p2.y = dpp_shr2(dpp_ror2(pv.y), cur.y);
                        const f32x2 cb2 = (f32x2){cbv[n][2 * jp], cbv[n][2 * jp + 1]}, w02 = (f32x2){w0[n][2 * jp], w0[n][2 * jp + 1]}, w12 = (f32x2){w1[n][2 * jp], w1[n][2 * jp + 1]}, w22 = (f32x2){w2[n][2 * jp], w2[n][2 * jp + 1]};
                        const f32x2 ac = cb2 + w02 * p2 + w12 * p1 + w22 * cur;
                        const f32x2 gg = gelu_t2(ac) * (f32x2){uu[n][2 * jp], uu[n][2 * jp + 1]};
                        g[2 * jp] = gg.x; g[2 * jp + 1] = gg.y; }
                    gpk[2 * n] = cvt_pk_bf16(g[0], g[1]); gpk[2 * n + 1] = cvt_pk_bf16(g[2], g[3]); }
                if (!(m == 0 && fr < 2)) *(u32x4*)(Gb + row * FF + c0) = (u32x4){gpk[0], gpk[1], gpk[2], gpk[3]};
                ap[0] = a[0]; ap[1] = a[1];
            }
        }
    }
};
struct EpiResid {
    bf16_t* XB; float* ss;
    __device__ __forceinline__ void operator()(const f32x4 (&acc)[2][2][4][2], const Unit& u, int ui, int wr, int wc, int fr, int fq) const {
        const size_t base = (size_t)(u.pm * BM + wr * 64 + fr) * 1024 + u.pn * BM + wc * 32 + 8 * fq;
        u32x4 xv[2][2];
#pragma unroll
        for (int bj = 0; bj < 2; ++bj) xv[0][bj] = *(const u32x4*)(XB + base + bj * HALF);
#pragma unroll
        for (int g = 0; g < 8; ++g) {
            const int ai = g >> 2, m = g & 3; const size_t off = base + (size_t)(ai * HALF + m * 16) * 1024;
            if (g < 7) { const int ai2 = (g + 1) >> 2, m2 = (g + 1) & 3; const size_t off2 = base + (size_t)(ai2 * HALF + m2 * 16) * 1024;
#pragma unroll
                for (int bj = 0; bj < 2; ++bj) xv[(g + 1) & 1][bj] = *(const u32x4*)(XB + off2 + bj * HALF); }
            float sq = 0.f;
#pragma unroll
            for (int bj = 0; bj < 2; ++bj) { const u32x4 xr = xv[g & 1][bj]; const f32x4 a0 = acc[ai][bj][m][0], a1 = acc[ai][bj][m][1];
                const float v0 = bflo(xr.x) + a0[0], v1 = bfhi(xr.x) + a0[1], v2 = bflo(xr.y) + a0[2], v3 = bfhi(xr.y) + a0[3];
                const float v4 = bflo(xr.z) + a1[0], v5 = bfhi(xr.z) + a1[1], v6 = bflo(xr.w) + a1[2], v7 = bfhi(xr.w) + a1[3];
                sq += v0 * v0 + v1 * v1 + v2 * v2 + v3 * v3 + v4 * v4 + v5 * v5 + v6 * v6 + v7 * v7;
                u32x4 o; o.x = cvt_pk_bf16(v0, v1); o.y = cvt_pk_bf16(v2, v3); o.z = cvt_pk_bf16(v4, v5); o.w = cvt_pk_bf16(v6, v7); *(u32x4*)(XB + off + bj * HALF) = o; }
            sq += __shfl_xor(sq, 16); sq += __shfl_xor(sq, 32);
            if (fq == 0) ss[(size_t)(u.pn * 4 + wc) * MTOK + u.pm * BM + ai * HALF + wr * 64 + m * 16 + fr] = sq;
        }
    }
};
}

constexpr int LDP = 136;
constexpr int TILE_B = 128 * LDP * 2;
__device__ __forceinline__ void stage_rows(LAS bf16_t* dst, const bf16_t* src, size_t ld, int tid) {
#pragma unroll
    for (int i = 0; i < 4; ++i) { const int idx = tid + 512 * i, r = idx >> 4, ch = idx & 15;
        const u32x4 v = *(const u32x4*)(src + (size_t)r * ld + ch * 8); *(LAS u32x4*)(dst + r * LDP + ch * 8) = v; }
}
template <bool SCALE>
__device__ __forceinline__ void stage_T(LAS bf16_t* dst, const bf16_t* src, size_t ld, LAS const float* wtok, int wid, int lane) {
    const int t0 = 2 * lane;
    float w0 = 1.f, w1 = 1.f; if (SCALE) { w0 = wtok[t0]; w1 = wtok[t0 + 1]; }
#pragma unroll
    for (int it = 0; it < 2; ++it) {
        const int fg = wid + 8 * it;
        const u32x4 va = *(const u32x4*)(src + (size_t)t0 * ld + fg * 8), vb = *(const u32x4*)(src + (size_t)(t0 + 1) * ld + fg * 8);
#pragma unroll
        for (int j = 0; j < 4; ++j) {
            unsigned lo, hi;
            if (SCALE) { lo = cvt_pk_bf16(bflo(va[j]) * w0, bflo(vb[j]) * w1); hi = cvt_pk_bf16(bfhi(va[j]) * w0, bfhi(vb[j]) * w1); }
            else { lo = (va[j] & 0xffffu) | (vb[j] << 16); hi = (va[j] >> 16) | (vb[j] & 0xffff0000u); }
            *(LAS unsigned*)(dst + (8 * fg + 2 * j) * LDP + t0) = lo;
            *(LAS unsigned*)(dst + (8 * fg + 2 * j + 1) * LDP + t0) = hi;
        }
    }
}
__device__ __forceinline__ void lds_gemm128(LAS const bf16_t* A, LAS const bf16_t* B, f32x4 (&acc)[2][4], int wr4, int wc2, int lane) {
    const int fr = lane & 15, fq = lane >> 4;
#pragma unroll
    for (int kk = 0; kk < 4; ++kk) {
        bf16x8 a[2], b[4];
#pragma unroll
        for (int mi = 0; mi < 2; ++mi) a[mi] = *(LAS const bf16x8*)(A + (32 * wr4 + 16 * mi + fr) * LDP + 32 * kk + 8 * fq);
#pragma unroll
        for (int ni = 0; ni < 4; ++ni) b[ni] = *(LAS const bf16x8*)(B + (64 * wc2 + 16 * ni + fr) * LDP + 32 * kk + 8 * fq);
#pragma unroll
        for (int mi = 0; mi < 2; ++mi)
#pragma unroll
            for (int ni = 0; ni < 4; ++ni) acc[mi][ni] = __builtin_amdgcn_mfma_f32_16x16x32_bf16(a[mi], b[ni], acc[mi][ni], 0, 0, 0);
    }
}
__device__ __forceinline__ void zero_acc(f32x4 (&acc)[2][4]) {
#pragma unroll
    for (int mi = 0; mi < 2; ++mi)
#pragma unroll
        for (int ni = 0; ni < 4; ++ni) acc[mi][ni] = (f32x4){0.f, 0.f, 0.f, 0.f};
}

__device__ __forceinline__ void transpose_item(CTJob& j, int item, LAS float* scr, int lane) {
    const int nblk = j.ncols / 32, kb = item / nblk, nb = item % nblk, k0 = 64 * kb, n0 = 32 * nb;
    float wv[32];
    const float* wp = j.W + (size_t)(k0 + (lane >> 5)) * j.ldw + n0 + (lane & 31);
#pragma unroll
    for (int i = 0; i < 32; ++i) wv[i] = wp[(size_t)(2 * i) * j.ldw];
    if (j.gk) {
#pragma unroll
        for (int i = 0; i < 32; ++i) wv[i] *= j.gk[k0 + 2 * i + (lane >> 5)]; }
#pragma unroll
    for (int i = 0; i < 32; ++i) scr[(2 * i + (lane >> 5)) * 33 + (lane & 31)] = wv[i];
    LDS_WAIT();
    const int c = lane & 7;
#pragma unroll
    for (int q = 0; q < 4; ++q) { const int n = (lane >> 3) + 8 * q; LAS const float* s = scr + (8 * c) * 33 + n;
        const int ng = n0 + n; const float sc = (ng >= j.n_lo && ng < j.n_hi) ? j.nscale : 1.f;
        u32x4 o; o.x = cvt_pk_bf16(s[0] * sc, s[33] * sc); o.y = cvt_pk_bf16(s[2 * 33] * sc, s[3 * 33] * sc); o.z = cvt_pk_bf16(s[4 * 33] * sc, s[5 * 33] * sc); o.w = cvt_pk_bf16(s[6 * 33] * sc, s[7 * 33] * sc);
        const int drow = j.rmode ? ((ng >> 7) * 256 + (ng & 127) + j.roff) : ng;
        *(u32x4*)(j.WT + (size_t)drow * j.ldt + k0 + 8 * c) = o; }
    LDS_WAIT();
}
__device__ __forceinline__ void phase_prep(CParams& P, LAS unsigned char* lds) {
    const int tid = get_tid(), wid = tid >> 6, lane = tid & 63;
    const int gw = get_bid() * 8 + wid, NGW = get_gdim() * 8;
    const int gt = get_bid() * 512 + tid, NGT = get_gdim() * 512;
    LAS float* scr = (LAS float*)(lds + wid * 8704);
#ifdef DEBUG_FILL
    { u32x4* bp = (u32x4*)(P.ws + WS_BIG); const size_t n16 = ((size_t)MTOK * AUW * 2) / 16; const u32x4 pv = (u32x4){DEBUG_FILL, DEBUG_FILL, DEBUG_FILL, DEBUG_FILL};
      for (size_t i = (size_t)get_bid() * 512 + tid; i < n16; i += (size_t)get_gdim() * 512) bp[i] = pv; }
#endif
    float* X = P.out; bf16_t* XB = (bf16_t*)(P.ws + WS_XB); float* SS = (float*)(P.ws + WS_SS);
    for (int row = gw; row < MTOK; row += NGW) {
        const float* src = row < MP ? P.in[0] + (size_t)row * 1024 : P.in[1] + (size_t)(row - MP) * 1024;
        float s = 0.f;
#pragma unroll
        for (int j = 0; j < 4; ++j) { const f32x4 v = *(const f32x4*)(src + 4 * lane + 256 * j);
            s += v[0] * v[0] + v[1] * v[1] + v[2] * v[2] + v[3] * v[3];
            u32x2 o; o.x = cvt_pk_bf16(v[0], v[1]); o.y = cvt_pk_bf16(v[2], v[3]); *(u32x2*)(XB + (size_t)row * 1024 + 4 * lane + 256 * j) = o; }
        s = wave_sum(s);
        if (lane < 16) SS[(size_t)lane * MTOK + row] = lane == 0 ? s : 0.f;
    }
    for (int it = gw; it < P.nitems; it += NGW) {
        int jb = 0;
#pragma unroll 1
        for (int q = 1; q < NJOBS; ++q) if (it >= P.jobs[q].item0) jb = q;
        transpose_item(P.jobs[jb], it - P.jobs[jb].item0, scr, lane);
    }
    float* WG = (float*)(P.ws + WS_WG);
    for (int i = gt; i < 2 * 8 * 1024; i += NGT) { const int e = i >> 13, j = (i >> 10) & 7, k = i & 1023;
        WG[i] = P.in[8][((size_t)e * 1024 + k) * 2568 + 2560 + j] * P.in[7][(2 * e) * 1024 + k]; }
    { bf16_t* WGB = (bf16_t*)(P.ws + WS_WGB);
      for (int i = gt; i < 2 * 16 * 1024 / 2; i += NGT) { const int i2 = i * 2, e = i2 >> 14, j = (i2 >> 10) & 15, k = i2 & 1023;
          float v0 = 0.f, v1 = 0.f;
          if (j < 8) { v0 = P.in[8][((size_t)e * 1024 + k) * 2568 + 2560 + j] * P.in[7][(2 * e) * 1024 + k]; v1 = P.in[8][((size_t)e * 1024 + k + 1) * 2568 + 2560 + j] * P.in[7][(2 * e) * 1024 + k + 1]; }
          *(unsigned*)(WGB + i2) = cvt_pk_bf16(v0, v1); } }
    bf16_t* WPOOL = (bf16_t*)(P.ws + WS_WPOOL);
    for (int i = gt; i < 2 * 4 * 128 * 128; i += NGT) { const int c = i & 127, d = (i >> 7) & 127, eg = i >> 14;
        const float mine = P.in[10][((size_t)eg * 128 + c) * 128 + d] * P.in[11][eg * 128 + d]; const float other = __shfl_xor(mine, 1);
        if (!(i & 1)) *(unsigned*)(WPOOL + i) = cvt_pk_bf16(mine, other); }
    bf16_t* WSP = (bf16_t*)(P.ws + WS_WSP);
    for (int i = gt; i < 2 * 4 * 128 * 128; i += NGT) { const int s = i & 127, r = (i >> 7) & 127;
        const float mine = s <= r ? P.in[17][i] : 0.f; const float other = __shfl_xor(mine, 1);
        if (!(i & 1)) *(unsigned*)(WSP + i) = cvt_pk_bf16(mine, other); }
}

__device__ __forceinline__ void phase_gates(CParams& P, int e, LAS unsigned char* lds) {
    const int tid = get_tid(), wid = tid >> 6, lane = tid & 63, fr = lane & 15, fq = lane >> 4;
    const bf16_t* XB = (const bf16_t*)(P.ws + WS_XB); const float* SS = (const float*)(P.ws + WS_SS); const bf16_t* WGB = (const bf16_t*)(P.ws + WS_WGB) + e * 16384;
    float* G = (float*)(P.ws + WS_BIG + B_GATES);
    LAS float* red = (LAS float*)lds;
    const int nbusy = (660 - 2 * get_gdim() > 0 && 660 - 2 * get_gdim() < get_gdim()) ? 660 - 2 * get_gdim() : 0;
    for (int u = get_bid() - nbusy; u < MTOK / 64; u += get_gdim() - nbusy) {
        if (u < 0) break;
        const int r0 = u * 64, k0 = wid * 128;
        f32x4 acc[4];
#pragma unroll
        for (int mi = 0; mi < 4; ++mi) acc[mi] = (f32x4){0.f, 0.f, 0.f, 0.f};
        bf16x8 a[4][4], b[4];
#pragma unroll
        for (int q = 0; q < 4; ++q) { b[q] = *(const bf16x8*)(WGB + (size_t)fr * 1024 + k0 + 32 * q + 8 * fq);
#pragma unroll
            for (int mi = 0; mi < 4; ++mi) a[q][mi] = *(const bf16x8*)(XB + (size_t)(r0 + 16 * mi + fr) * 1024 + k0 + 32 * q + 8 * fq); }
#pragma unroll
        for (int q = 0; q < 4; ++q)
#pragma unroll
            for (int mi = 0; mi < 4; ++mi) acc[mi] = __builtin_amdgcn_mfma_f32_16x16x32_bf16(a[q][mi], b[q], acc[mi], 0, 0, 0);
#pragma unroll
        for (int mi = 0; mi < 4; ++mi)
#pragma unroll
            for (int j = 0; j < 4; ++j) red[wid * 1024 + (16 * mi + 4 * fq + j) * 16 + fr] = acc[mi][j];
        __syncthreads();
        { const int row = tid >> 3, j = tid & 7;
          float v = 0.f;
#pragma unroll
          for (int w = 0; w < 8; ++w) v += red[w * 1024 + row * 16 + j];
          float s2 = 0.f;
#pragma unroll
          for (int q = 0; q < 16; ++q) s2 += SS[(size_t)q * MTOK + r0 + row];
          v = v * rsqrtf(s2 * (1.f / 1024.f) + EPS) + P.in[9][e * 8 + j];
          if (j >= 4) v = fminf(v, 0.f) - log1pf(__expf(-fabsf(v)));
          G[(size_t)(r0 + row) * 8 + j] = v; }
        __syncthreads();
    }
}

__device__ __forceinline__ void e2_unit(CParams& P, int unit, LAS unsigned char* lds) {
    const int tid = get_tid(), wid = tid >> 6, lane = tid & 63;
    const int b = unit >> 6, h = (unit >> 4) & 3, c = unit & 15;
    unsigned char* big = P.ws + WS_BIG;
    const bf16_t* ZB = (const bf16_t*)(big + B_ZB); const float* G = (const float*)(big + B_GATES);
    float* BT = (float*)(big + B_BT); float* SCAL = (float*)(big + B_SCAL); float* DC = (float*)(big + B_DC); float* DN = (float*)(big + B_DN);
    LAS bf16_t* VT = (LAS bf16_t*)lds; LAS bf16_t* KW = (LAS bf16_t*)(lds + TILE_B);
    LAS float* sB = (LAS float*)(lds + 2 * TILE_B); LAS float* sM = sB + 16; LAS float* sg = sB + 32; LAS float* sw = sB + 160;
    for (int cc = wid; cc <= c; cc += 8) {
        const size_t tb = (size_t)b * 2048 + cc * 128 + 2 * lane;
        const float lf0 = G[tb * 8 + 4 + h], lf1 = G[(tb + 1) * 8 + 4 + h], ig0 = G[tb * 8 + h], ig1 = G[(tb + 1) * 8 + h];
        const float pair = lf0 + lf1; float incl = pair;
#pragma unroll
        for (int o = 1; o < 64; o <<= 1) { const float t = __shfl_up(incl, o); if (lane >= o) incl += t; }
        const float b1 = incl, b0 = incl - lf1;
        const float Btot = __shfl(incl, 63);
        const float g0 = ig0 - b0, g1 = ig1 - b1; const float mx = wave_max(fmaxf(g0, g1));
        if (lane == 0) { sB[cc] = Btot; sM[cc] = Btot + mx; }
        if (cc == c) { sg[2 * lane] = g0; sg[2 * lane + 1] = g1; BT[tb * 4 + h] = b0; BT[(tb + 1) * 4 + h] = b1; }
    }
    __syncthreads();
    float m = 0.f, mprev = 0.f;
    for (int cc = 0; cc <= c; ++cc) { mprev = m; m = fmaxf(sB[cc] + m, sM[cc]); }
    const float Bc = sB[c];
    if (tid < 128) sw[tid] = __expf(Bc + sg[tid] - m);
    if (tid == 0) { SCAL[unit * 4 + 0] = mprev; SCAL[unit * 4 + 1] = m; SCAL[unit * 4 + 2] = Bc; }
    __syncthreads();
    const bf16_t* zrow = ZB + ((size_t)b * 2048 + c * 128) * NZ;
    stage_T<false>(VT, zrow + 1536 + h * 128, NZ, sw, wid, lane);
    stage_T<true>(KW, zrow + 1024 + h * 128, NZ, sw, wid, lane);
    __syncthreads();
    f32x4 acc[2][4]; zero_acc(acc);
    const int wr4 = wid >> 1, wc2 = wid & 1, fr = lane & 15, fq = lane >> 4;
    lds_gemm128(VT, KW, acc, wr4, wc2, lane);
    float* dc = DC + (size_t)unit * 16384;
#pragma unroll
    for (int mi = 0; mi < 2; ++mi)
#pragma unroll
        for (int ni = 0; ni < 4; ++ni)
#pragma unroll
            for (int j = 0; j < 4; ++j) dc[(32 * wr4 + 16 * mi + 4 * fq + j) * 128 + 64 * wc2 + 16 * ni + fr] = acc[mi][ni][j];
    if (tid < 128) { float s = 0.f;
#pragma unroll
        for (int i = 0; i < 16; ++i) { const u32x4 v = *(LAS const u32x4*)(KW + tid * LDP + 8 * i); float f[8]; unpack8(v, f);
#pragma unroll
            for (int q = 0; q < 8; ++q) s += f[q]; }
        DN[unit * 128 + tid] = s; }
    __syncthreads();
}

__device__ __forceinline__ void pool_unit(CParams& P, int e, int tile, int g, LAS unsigned char* lds) {
    const int tid = get_tid(), wid = tid >> 6, lane = tid & 63;
    unsigned char* big = P.ws + WS_BIG;
    const bf16_t* ZB = (const bf16_t*)(big + B_ZB); bf16_t* YMIX = (bf16_t*)(big + B_YMIX);
    const bf16_t* WPOOL = (const bf16_t*)(P.ws + WS_WPOOL) + (size_t)(e * 4 + g) * 16384;
    LAS bf16_t* A = (LAS bf16_t*)lds; LAS bf16_t* Bm = (LAS bf16_t*)(lds + TILE_B); LAS bf16_t* R = (LAS bf16_t*)(lds + 2 * TILE_B);
    const int w = 2 << g; const int tok0 = tile * 128;
    stage_rows(Bm, WPOOL, 128, tid);
    if (tile < 128) {
        const int tpos0 = tok0 & 2047;
        for (int idx = tid; idx < 143 * 16; idx += 512) { const int r = idx >> 4, ch = idx & 15;
            u32x4 v = (u32x4){0u, 0u, 0u, 0u};
            if (tpos0 - 15 + r >= 0) v = *(const u32x4*)(ZB + (size_t)(tok0 - 15 + r) * NZ + g * 128 + ch * 8);
            *(LAS u32x4*)(R + r * LDP + ch * 8) = v; }
        __syncthreads();
#pragma unroll 1
        for (int i = 0; i < 4; ++i) {
            const int idx = tid + 512 * i, t = idx >> 4, cg8 = idx & 15, tpos = tpos0 + t, col = g * 128 + cg8 * 8;
            float sum[8], self[8], f[8];
            unpack8(*(LAS const u32x4*)(R + (t + 15) * LDP + cg8 * 8), self);
#pragma unroll
            for (int q = 0; q < 8; ++q) sum[q] = self[q];
            for (int ii = 1; ii < w; ++ii) { unpack8(*(LAS const u32x4*)(R + (t + 15 - ii) * LDP + cg8 * 8), f);
#pragma unroll
                for (int q = 0; q < 8; ++q) sum[q] += f[q]; }
            if (tpos >= 2033) { float* o = P.out + O_POOLP + ((size_t)(e * 8 + (tok0 >> 11)) * 15 + (tpos - 2033)) * 512 + col;
                *(f32x4*)o = (f32x4){self[0], self[1], self[2], self[3]}; *(f32x4*)(o + 4) = (f32x4){self[4], self[5], self[6], self[7]}; }
            const float ic = 1.f / (float)min(w, tpos + 1); float d[8];
#pragma unroll
            for (int q = 0; q < 8; ++q) d[q] = sum[q] * ic - self[q];
            *(LAS u32x4*)(A + t * LDP + cg8 * 8) = pack8(d);
        }
    } else {
        const int seq = tid >> 4, cg8 = tid & 15, col = g * 128 + cg8 * 8; const int bs = ((tok0 - MP) >> 2) + seq;
        const float* sp = P.in[2] + ((size_t)(e * 128 + bs) * 15) * 512 + col;
        float* ob = P.out + O_POOLS + ((size_t)(e * 128 + bs) * 15) * 512 + col;
        float run[8], lo[4][8], hi[4][8], self[4][8];
#pragma unroll
        for (int q = 0; q < 8; ++q) { run[q] = 0.f;
#pragma unroll
            for (int t = 0; t < 4; ++t) lo[t][q] = 0.f; }
#pragma unroll
        for (int k = 0; k < 19; ++k) {
            float row[8];
            if (k < 15) { const f32x4 r0 = *(const f32x4*)(sp + (size_t)k * 512), r1 = *(const f32x4*)(sp + (size_t)k * 512 + 4);
                row[0] = r0[0]; row[1] = r0[1]; row[2] = r0[2]; row[3] = r0[3]; row[4] = r1[0]; row[5] = r1[1]; row[6] = r1[2]; row[7] = r1[3]; }
            else unpack8(*(const u32x4*)(ZB + (size_t)(MP + bs * 4 + (k - 15)) * NZ + col), row);
            if (k >= 4) { float* o = ob + (size_t)(k - 4) * 512; *(f32x4*)o = (f32x4){row[0], row[1], row[2], row[3]}; *(f32x4*)(o + 4) = (f32x4){row[4], row[5], row[6], row[7]}; }
#pragma unroll
            for (int q = 0; q < 8; ++q) run[q] += row[q];
#pragma unroll
            for (int t = 0; t < 4; ++t) {
                if (k == 15 + t - w) {
#pragma unroll
                    for (int q = 0; q < 8; ++q) lo[t][q] = run[q]; }
                if (k == 15 + t) {
#pragma unroll
                    for (int q = 0; q < 8; ++q) { hi[t][q] = run[q]; self[t][q] = row[q]; } }
            }
        }
        const float ic = 1.f / (float)w;
#pragma unroll
        for (int t = 0; t < 4; ++t) { float d[8];
#pragma unroll
            for (int q = 0; q < 8; ++q) d[q] = (hi[t][q] - lo[t][q]) * ic - self[t][q];
            *(LAS u32x4*)(A + (seq * 4 + t) * LDP + cg8 * 8) = pack8(d); }
    }
    __syncthreads();
    f32x4 acc[2][4]; zero_acc(acc);
    const int wr4 = wid >> 1, wc2 = wid & 1, fr = lane & 15, fq = lane >> 4;
    lds_gemm128(A, Bm, acc, wr4, wc2, lane);
#pragma unroll
    for (int mi = 0; mi < 2; ++mi)
#pragma unroll
        for (int ni = 0; ni < 4; ++ni)
#pragma unroll
            for (int j = 0; j < 4; ++j) { const float mine = acc[mi][ni][j]; const float other = __shfl_xor(mine, 1);
                if (!(fr & 1)) *(unsigned*)(YMIX + (size_t)(tok0 + 32 * wr4 + 16 * mi + 4 * fq + j) * 1024 + g * 128 + 64 * wc2 + 16 * ni + fr) = cvt_pk_bf16(mine, other); }
    __syncthreads();
}

__device__ __forceinline__ void phase_scan(CParams& P, int e, LAS unsigned char* lds) {
    unsigned char* big = P.ws + WS_BIG;
    const float* SCAL = (const float*)(big + B_SCAL); const float* DC = (const float*)(big + B_DC); const float* DN = (const float*)(big + B_DN);
    bf16_t* CPREV = (bf16_t*)(big + B_CPREV); float* NPREV = (float*)(big + B_NPREV);
    const int gt = get_bid() * 512 + get_tid(), NGT = get_gdim() * 512;
    for (int i = gt; i < 32 * 4096; i += NGT) {
        const int bh = i >> 12, e4 = (i & 4095) * 4;
        f32x4 st = (f32x4){0.f, 0.f, 0.f, 0.f}; f32x4 dcv[16]; float aLv[16];
#pragma unroll
        for (int c = 0; c < 16; ++c) { const int unit = bh * 16 + c; dcv[c] = *(const f32x4*)(DC + (size_t)unit * 16384 + e4);
            aLv[c] = __expf(SCAL[unit * 4 + 2] + SCAL[unit * 4 + 0] - SCAL[unit * 4 + 1]); }
#pragma unroll
        for (int c = 0; c < 16; ++c) {
            const int unit = bh * 16 + c;
            u32x2 o; o.x = cvt_pk_bf16(st[0], st[1]); o.y = cvt_pk_bf16(st[2], st[3]); *(u32x2*)(CPREV + (size_t)unit * 16384 + e4) = o;
            st = st * aLv[c] + dcv[c];
        }
        const int v = e4 >> 7, k = e4 & 127;
        float* o = P.out + O_CP + ((size_t)(e * 32 + bh) * 128) * 128;
        if (NGT == 32 * 4096) {
            LAS float* T = (LAS float*)lds; const int tid = i & 511, vl = tid >> 5;
            *(LAS f32x4*)(T + vl * 132 + k) = st;
            __syncthreads();
            const int k2 = tid >> 2, vq = tid & 3; const int v0 = (e4 >> 7) - vl;
            f32x4 t4; t4[0] = T[(4 * vq + 0) * 132 + k2]; t4[1] = T[(4 * vq + 1) * 132 + k2]; t4[2] = T[(4 * vq + 2) * 132 + k2]; t4[3] = T[(4 * vq + 3) * 132 + k2];
            *(f32x4*)(o + (size_t)k2 * 128 + v0 + 4 * vq) = t4;
            __syncthreads();
        } else {
#pragma unroll
            for (int q = 0; q < 4; ++q) o[(size_t)(k + q) * 128 + v] = st[q];
        }
    }
    for (int i = gt; i < 32 * 128; i += NGT) {
        const int bh = i >> 7, k = i & 127; float st = 0.f; float dnv[16], aLn[16];
#pragma unroll
        for (int c = 0; c < 16; ++c) { const int unit = bh * 16 + c; dnv[c] = DN[unit * 128 + k]; aLn[c] = __expf(SCAL[unit * 4 + 2] + SCAL[unit * 4 + 0] - SCAL[unit * 4 + 1]); }
#pragma unroll
        for (int c = 0; c < 16; ++c) { const int unit = bh * 16 + c; NPREV[unit * 128 + k] = st; st = st * aLn[c] + dnv[c]; }
        P.out[O_NP + (size_t)(e * 32 + bh) * 128 + k] = st;
    }
    if (gt < 32) P.out[O_MP + e * 32 + gt] = SCAL[(gt * 16 + 15) * 4 + 1];
}
__device__ __forceinline__ void mlstm_sample_unit(CParams& P, int e, int unit, LAS unsigned char* lds) {
    const int tid = get_tid(), lane = tid & 63;
    const int bs = unit >> 2, h = unit & 3; const int tokS = MP + bs * 4;
    unsigned char* big = P.ws + WS_BIG;
    const bf16_t* ZB = (const bf16_t*)(big + B_ZB); const float* G = (const float*)(big + B_GATES); bf16_t* YMIX = (bf16_t*)(big + B_YMIX);
    LAS float* sq = (LAS float*)lds; LAS float* sk = sq + 512; LAS float* sv = sq + 1024; LAS float* swk = sq + 1536; LAS float* sqc = sq + 2048;
    LAS float* sS = sq + 4096; LAS float* sqn = sS + 16; LAS float* shs = sqn + 4;
    const size_t sidx = (size_t)(e * 128 + bs) * 4 + h;
    const float* C0 = P.in[3] + sidx * 16384; const float* n0 = P.in[4] + sidx * 128; const float m0 = P.in[5][sidx];
    for (int idx = tid; idx < 1536; idx += 512) { const int which = idx >> 9, t = (idx >> 7) & 3, f = idx & 127;
        sq[idx] = bf2f(ZB[(size_t)(tokS + t) * NZ + 512 + which * 512 + h * 128 + f]); }
    float ig[4], bb[4], mt[4], at[4]; float cs = 0.f;
#pragma unroll
    for (int t = 0; t < 4; ++t) { ig[t] = G[(size_t)(tokS + t) * 8 + h]; cs += G[(size_t)(tokS + t) * 8 + 4 + h]; bb[t] = cs; }
#pragma unroll
    for (int t = 0; t < 4; ++t) { float mm = bb[t] + m0;
#pragma unroll
        for (int s = 0; s < 4; ++s) if (s <= t) mm = fmaxf(mm, bb[t] - bb[s] + ig[s]);
        mt[t] = mm; at[t] = __expf(bb[t] + m0 - mm); }
    const float mnew = mt[3]; const float aL = __expf(bb[3] + m0 - mnew);
    float ws[4];
#pragma unroll
    for (int s = 0; s < 4; ++s) ws[s] = __expf(bb[3] - bb[s] + ig[s] - mnew);
    __syncthreads();
    {
        const int p = tid >> 5, l32 = tid & 31, t = p >> 2, s = p & 3;
        float d = 0.f;
#pragma unroll
        for (int q = 0; q < 4; ++q) d += sq[t * 128 + l32 * 4 + q] * sk[s * 128 + l32 * 4 + q];
#pragma unroll
        for (int o = 1; o < 32; o <<= 1) d += __shfl_xor(d, o);
        float bt = 0.f, bsv = 0.f, igs = 0.f, mtt = 0.f;
#pragma unroll
        for (int q = 0; q < 4; ++q) { if (q == t) { bt = bb[q]; mtt = mt[q]; } if (q == s) { bsv = bb[q]; igs = ig[q]; } }
        if (l32 == 0) sS[p] = (s <= t) ? d * __expf(bt - bsv + igs - mtt) : 0.f;
        if (p < 4) { float d2 = 0.f;
#pragma unroll
            for (int q = 0; q < 4; ++q) d2 += sq[p * 128 + l32 * 4 + q] * n0[l32 * 4 + q];
#pragma unroll
            for (int o = 1; o < 32; o <<= 1) d2 += __shfl_xor(d2, o);
            if (l32 == 0) sqn[p] = d2; }
        const int s2 = tid >> 7, k2 = tid & 127; float wv = 0.f;
#pragma unroll
        for (int q = 0; q < 4; ++q) if (q == s2) wv = ws[q];
        swk[tid] = wv * sk[s2 * 128 + k2];
    }
    __syncthreads();
    {
        const int v = tid & 127, kq = tid >> 7; float qc[4] = {0.f, 0.f, 0.f, 0.f};
        float* Co = P.out + O_CS + sidx * 16384;
        const float v0 = sv[v], v1 = sv[128 + v], v2 = sv[256 + v], v3 = sv[384 + v];
#pragma unroll 1
        for (int kb = 0; kb < 32; kb += 16) {
            float c0v[16];
#pragma unroll
            for (int kk = 0; kk < 16; ++kk) c0v[kk] = C0[(kq * 32 + kb + kk) * 128 + v];
#pragma unroll
            for (int kk = 0; kk < 16; ++kk) { const int k = kq * 32 + kb + kk; const float c0 = c0v[kk];
                Co[k * 128 + v] = aL * c0 + swk[k] * v0 + swk[128 + k] * v1 + swk[256 + k] * v2 + swk[384 + k] * v3;
#pragma unroll
                for (int t = 0; t < 4; ++t) qc[t] += sq[t * 128 + k] * c0; }
        }
#pragma unroll
        for (int t = 0; t < 4; ++t) sqc[(kq * 4 + t) * 128 + v] = qc[t];
        if (tid < 128) P.out[O_NS + sidx * 128 + tid] = aL * n0[tid] + swk[tid] + swk[128 + tid] + swk[256 + tid] + swk[384 + tid];
        if (tid == 0) P.out[O_MS + sidx] = mnew;
    }
    __syncthreads();
    const int t = tid >> 7, v = tid & 127;
    float att = 0.f, mtt = 0.f;
#pragma unroll
    for (int q = 0; q < 4; ++q) if (q == t) { att = at[q]; mtt = mt[q]; }
    const float qC = sqc[(0 * 4 + t) * 128 + v] + sqc[(1 * 4 + t) * 128 + v] + sqc[(2 * 4 + t) * 128 + v] + sqc[(3 * 4 + t) * 128 + v];
    float den = att * sqn[t], num = att * qC;
#pragma unroll
    for (int s = 0; s < 4; ++s) { const float Sv = sS[t * 4 + s]; den += Sv; num += Sv * sv[s * 128 + v]; }
    const float hv = num / fmaxf(fabsf(den), __expf(-mtt));
    const float hsq = wave_sum(hv * hv);
    if (lane == 0) shs[t * 2 + ((tid >> 6) & 1)] = hsq;
    __syncthreads();
    const float rn = rsqrtf((shs[t * 2] + shs[t * 2 + 1]) * (1.f / 128.f) + EPS);
    const int col = h * 128 + v;
    const float o = bf2f(ZB[(size_t)(tokS + t) * NZ + 2048 + col]);
    { const float mine = sigmoidf_(o) * hv * rn * P.in[12][e * 512 + col]; const float other = __shfl_xor(mine, 1);
      if (!(v & 1)) *(unsigned*)(YMIX + (size_t)(tokS + t) * 1024 + 512 + col) = cvt_pk_bf16(mine, other); }
    __syncthreads();
}

__device__ __forceinline__ void e4_unit(CParams& P, int e, int unit, LAS unsigned char* lds) {
    const int tid = get_tid(), wid = tid >> 6, lane = tid & 63;
    const int b = unit >> 6, h = (unit >> 4) & 3, c = unit & 15; const int tok0 = b * 2048 + c * 128;
    unsigned char* big = P.ws + WS_BIG;
    const bf16_t* ZB = (const bf16_t*)(big + B_ZB); const float* G = (const float*)(big + B_GATES);
    const float* BT = (const float*)(big + B_BT); const float* SCAL = (const float*)(big + B_SCAL);
    const bf16_t* CPREV = (const bf16_t*)(big + B_CPREV); const float* NPREV = (const float*)(big + B_NPREV); bf16_t* YMIX = (bf16_t*)(big + B_YMIX);
    LAS bf16_t* Q = (LAS bf16_t*)lds; LAS bf16_t* Kb = (LAS bf16_t*)(lds + TILE_B); LAS bf16_t* VT = (LAS bf16_t*)(lds + 2 * TILE_B); LAS bf16_t* CT = (LAS bf16_t*)(lds + 3 * TILE_B);
    LAS float* sm = (LAS float*)(lds + 4 * TILE_B);
    LAS float* sgs = sm; LAS float* smt = sm + 128; LAS float* set = sm + 256; LAS float* sat = sm + 384; LAS float* rsum = sm + 512  ;
    LAS float* hs = sm + 768  ; LAS float* sdinv = sm + 1024; LAS float* sqn = sm + 1152; LAS float* snp = sm + 1280; LAS float* sbt = sm + 1408;
    const bf16_t* zrow = ZB + (size_t)tok0 * NZ;
    stage_rows(Q, zrow + 512 + h * 128, NZ, tid);
    stage_rows(Kb, zrow + 1024 + h * 128, NZ, tid);
    stage_T<false>(VT, zrow + 1536 + h * 128, NZ, sm, wid, lane);
    stage_rows(CT, CPREV + (size_t)unit * 16384, 128, tid);
    const float mprev = SCAL[unit * 4 + 0];
    if (tid < 128) { const float bt = BT[(size_t)(tok0 + tid) * 4 + h], igv = G[(size_t)(tok0 + tid) * 8 + h]; sbt[tid] = bt; sgs[tid] = igv - bt; snp[tid] = NPREV[unit * 128 + tid]; }
    __syncthreads();
    if (tid < 128) {
        float cm = sgs[tid];
#pragma unroll
        for (int o = 1; o < 64; o <<= 1) { const float t2 = __shfl_up(cm, o); if (lane >= o) cm = fmaxf(cm, t2); }
        if (tid >= 64) { float m0 = sgs[lane]; m0 = wave_max(m0); cm = fmaxf(cm, m0); }
        const float bt = sbt[tid]; const float mt = bt + fmaxf(mprev, cm);
        smt[tid] = mt; set[tid] = bt - mt; sat[tid] = __expf(bt + mprev - mt);
        float qn = 0.f;
#pragma unroll
        for (int i = 0; i < 16; ++i) { float f[8]; unpack8(*(LAS const u32x4*)(Q + tid * LDP + 8 * i), f);
#pragma unroll
            for (int q = 0; q < 8; ++q) qn += f[q] * snp[8 * i + q]; }
        sqn[tid] = qn;
    }
    const int wr4 = wid >> 1, wc2 = wid & 1, fr = lane & 15, fq = lane >> 4;
    f32x4 acc1[2][4]; zero_acc(acc1);
    lds_gemm128(Q, Kb, acc1, wr4, wc2, lane);
    __syncthreads();
#pragma unroll
    for (int mi = 0; mi < 2; ++mi)
#pragma unroll
        for (int j = 0; j < 4; ++j) {
            const int t = 32 * wr4 + 16 * mi + 4 * fq + j; const float et = set[t]; float rs = 0.f;
#pragma unroll
            for (int ni = 0; ni < 4; ++ni) { const int s = 64 * wc2 + 16 * ni + fr;
                const float p = (s <= t) ? acc1[mi][ni][j] * __expf(et + sgs[s]) : 0.f; rs += p; const float po = __shfl_xor(p, 1);
                if (!(fr & 1)) *(LAS unsigned*)(Kb + t * LDP + s) = cvt_pk_bf16(p, po); }
            rs += __shfl_xor(rs, 1); rs += __shfl_xor(rs, 2); rs += __shfl_xor(rs, 4); rs += __shfl_xor(rs, 8);
            if (fr == 0) rsum[wc2 * 128 + t] = rs;
        }
    __syncthreads();
    if (tid < 128) { const float den = sat[tid] * sqn[tid] + rsum[tid] + rsum[128 + tid]; sdinv[tid] = 1.f / fmaxf(fabsf(den), __expf(-smt[tid])); }
    f32x4 acc2[2][4]; zero_acc(acc1); zero_acc(acc2);
    bf16_t og[2][4][4]; float gh[4];
#pragma unroll
    for (int ni = 0; ni < 4; ++ni) gh[ni] = P.in[12][e * 512 + h * 128 + 64 * wc2 + 16 * ni + fr];
#pragma unroll
    for (int mi = 0; mi < 2; ++mi)
#pragma unroll
        for (int j = 0; j < 4; ++j)
#pragma unroll
            for (int ni = 0; ni < 4; ++ni) og[mi][j][ni] = ZB[(size_t)(tok0 + 32 * wr4 + 16 * mi + 4 * fq + j) * NZ + 2048 + h * 128 + 64 * wc2 + 16 * ni + fr];
    lds_gemm128(Kb, VT, acc1, wr4, wc2, lane);
    lds_gemm128(Q, CT, acc2, wr4, wc2, lane);
    __syncthreads();
#pragma unroll
    for (int mi = 0; mi < 2; ++mi)
#pragma unroll
        for (int j = 0; j < 4; ++j) {
            const int t = 32 * wr4 + 16 * mi + 4 * fq + j; const float a = sat[t], di = sdinv[t]; float sq = 0.f;
#pragma unroll
            for (int ni = 0; ni < 4; ++ni) { const float hv = (a * acc2[mi][ni][j] + acc1[mi][ni][j]) * di; acc1[mi][ni][j] = hv; sq += hv * hv; }
            sq += __shfl_xor(sq, 1); sq += __shfl_xor(sq, 2); sq += __shfl_xor(sq, 4); sq += __shfl_xor(sq, 8);
            if (fr == 0) hs[wc2 * 128 + t] = sq;
        }
    __syncthreads();
#pragma unroll
    for (int mi = 0; mi < 2; ++mi)
#pragma unroll
        for (int j = 0; j < 4; ++j) {
            const int t = 32 * wr4 + 16 * mi + 4 * fq + j; const float rn = rsqrtf((hs[t] + hs[128 + t]) * (1.f / 128.f) + EPS);
#pragma unroll
            for (int ni = 0; ni < 4; ++ni) { const int col = h * 128 + 64 * wc2 + 16 * ni + fr;
                const float mine = sigmoidf_(bf2f(og[mi][j][ni])) * acc1[mi][ni][j] * rn * gh[ni]; const float other = __shfl_xor(mine, 1);
                if (!(fr & 1)) *(unsigned*)(YMIX + (size_t)(tok0 + t) * 1024 + 512 + col) = cvt_pk_bf16(mine, other); }
        }
    __syncthreads();
}

__device__ __forceinline__ void sgu_unit(CParams& P, int o, int unit, LAS unsigned char* lds) {
    const int tid = get_tid(), wid = tid >> 6, lane = tid & 63;
    const int g = unit & 3, tile = unit >> 2; const int tok0 = tile * 128;
    unsigned char* big = P.ws + WS_BIG;
    const bf16_t* U = (const bf16_t*)(big + B_U); const bf16_t* VPRE = (const bf16_t*)(big + B_VPRE); const float* LNS = (const float*)(big + B_LNS); bf16_t* US = (bf16_t*)(big + B_US);
    const bf16_t* WSP = (const bf16_t*)(P.ws + WS_WSP) + (size_t)(o * 4 + g) * 16384;
    LAS bf16_t* A = (LAS bf16_t*)lds; LAS bf16_t* B0 = (LAS bf16_t*)(lds + TILE_B); LAS bf16_t* B1 = (LAS bf16_t*)(lds + 2 * TILE_B);
    LAS float* smu = (LAS float*)(lds + 3 * TILE_B); LAS float* srs = smu + 128;
    stage_rows(A, WSP, 128, tid);
    if (tid < 128) { float s = 0.f, q = 0.f;
#pragma unroll
        for (int j = 0; j < 16; ++j) { s += LNS[(size_t)j * MTOK + tok0 + tid]; q += LNS[(size_t)(16 + j) * MTOK + tok0 + tid]; }
        const float mu = s * (1.f / 1024.f); smu[tid] = mu; srs[tid] = rsqrtf(fmaxf(q * (1.f / 1024.f) - mu * mu, 0.f) + EPS); }
    __syncthreads();
    {
        const int t0 = 2 * lane; const float mu0 = smu[t0], mu1 = smu[t0 + 1], r0 = srs[t0], r1 = srs[t0 + 1];
#pragma unroll
        for (int half = 0; half < 2; ++half) {
            LAS bf16_t* dst = half ? B1 : B0;
#pragma unroll
            for (int it = 0; it < 2; ++it) {
                const int fg = wid + 8 * it; const int ch0 = g * 256 + half * 128 + fg * 8;
                float fa[8], fb[8];
                unpack8(*(const u32x4*)(VPRE + (size_t)(tok0 + t0) * 1024 + ch0), fa); unpack8(*(const u32x4*)(VPRE + (size_t)(tok0 + t0 + 1) * 1024 + ch0), fb);
                const f32x4 lg0 = *(const f32x4*)(P.in[15] + o * 1024 + ch0), lg1 = *(const f32x4*)(P.in[15] + o * 1024 + ch0 + 4), lb0 = *(const f32x4*)(P.in[16] + o * 1024 + ch0), lb1 = *(const f32x4*)(P.in[16] + o * 1024 + ch0 + 4);
#pragma unroll
                for (int q = 0; q < 8; ++q) { const float lg = q < 4 ? lg0[q & 3] : lg1[q & 3], lb = q < 4 ? lb0[q & 3] : lb1[q & 3];
                    *(LAS unsigned*)(dst + (8 * fg + q) * LDP + t0) = cvt_pk_bf16((fa[q] - mu0) * r0 * lg + lb, (fb[q] - mu1) * r1 * lg + lb); }
            }
        }
    }
    __syncthreads();
    const int wr4 = wid >> 1, wc2 = wid & 1, fr = lane & 15, fq = lane >> 4;
    f32x4 acc0[2][4], acc1[2][4]; zero_acc(acc0); zero_acc(acc1);
    lds_gemm128(A, B0, acc0, wr4, wc2, lane);
    lds_gemm128(A, B1, acc1, wr4, wc2, lane);
#pragma unroll
    for (int mi = 0; mi < 2; ++mi) {
        bf16_t uv[4][4][2]; float bsr[4];
#pragma unroll
        for (int j = 0; j < 4; ++j) { const int r = 32 * wr4 + 16 * mi + 4 * fq + j; bsr[j] = P.in[18][(o * 4 + g) * 128 + r]; const size_t rowo = (size_t)(tok0 + r) * 1024 + g * 256;
#pragma unroll
            for (int ni = 0; ni < 4; ++ni) { const int d = 64 * wc2 + 16 * ni + fr; uv[j][ni][0] = U[rowo + d]; uv[j][ni][1] = U[rowo + 128 + d]; } }
#pragma unroll
        for (int j = 0; j < 4; ++j) {
            const int r = 32 * wr4 + 16 * mi + 4 * fq + j; const float bsv = bsr[j]; const size_t rowo = (size_t)(tok0 + r) * 1024 + g * 256;
#pragma unroll
            for (int ni = 0; ni < 4; ++ni) { const int d = 64 * wc2 + 16 * ni + fr;
                const float m0 = bf2f(uv[j][ni][0]) * (acc0[mi][ni][j] + bsv), m1 = bf2f(uv[j][ni][1]) * (acc1[mi][ni][j] + bsv);
                const float o0 = __shfl_xor(m0, 1), o1 = __shfl_xor(m1, 1);
                if (!(fr & 1)) { *(unsigned*)(US + rowo + d) = cvt_pk_bf16(m0, o0); *(unsigned*)(US + rowo + 128 + d) = cvt_pk_bf16(m1, o1); } }
        }
    }
    __syncthreads();
}
__device__ __forceinline__ void sgu_sample(CParams& P, int o) {
    const int tid = get_tid(), wid = tid >> 6, lane = tid & 63;
    unsigned char* big = P.ws + WS_BIG;
    const bf16_t* U = (const bf16_t*)(big + B_U); const bf16_t* VPRE = (const bf16_t*)(big + B_VPRE); const float* LNS = (const float*)(big + B_LNS); bf16_t* US = (bf16_t*)(big + B_US);
    for (int bs = get_bid(); bs < 128; bs += get_gdim()) {
        const int tokS = MP + bs * 4; float mu[4], rs[4];
#pragma unroll
        for (int t = 0; t < 4; ++t) { float s = lane < 16 ? LNS[(size_t)lane * MTOK + tokS + t] : 0.f, q = lane < 16 ? LNS[(size_t)(16 + lane) * MTOK + tokS + t] : 0.f;
            s = wave_sum(s); q = wave_sum(q); mu[t] = s * (1.f / 1024.f); rs[t] = rsqrtf(fmaxf(q * (1.f / 1024.f) - mu[t] * mu[t], 0.f) + EPS); }
        for (int i = 2 * wid; i < 2 * wid + 2; ++i) { const int d = lane + 64 * i, g = d >> 8; const float lg = P.in[15][o * 1024 + d], lb = P.in[16][o * 1024 + d];
            float vl[4];
#pragma unroll
            for (int t = 0; t < 4; ++t) { vl[t] = (bf2f(VPRE[(size_t)(tokS + t) * 1024 + d]) - mu[t]) * rs[t] * lg + lb;
                P.out[O_V + ((size_t)(o * 128 + bs) * 4 + t) * 1024 + d] = vl[t]; }
#pragma unroll
            for (int t = 0; t < 4; ++t) { float s = P.in[18][(o * 4 + g) * 128 + t];
#pragma unroll
                for (int s2 = 0; s2 < 4; ++s2) if (s2 <= t) s += P.in[17][((size_t)(o * 4 + g) * 128 + t) * 128 + s2] * vl[s2];
                const float mine = bf2f(U[(size_t)(tokS + t) * 1024 + d]) * s; const float other = __shfl_xor(mine, 1);
                if (!(lane & 1)) *(unsigned*)(US + (size_t)(tokS + t) * 1024 + d) = cvt_pk_bf16(mine, other); }
        }
    }
}

__device__ __forceinline__ void conv_item(const float (&e0)[8], const float (&e1)[8], const float (&a2)[8], const float (&uu)[8], LAS const float* wl, int n, bf16_t* dst) {
    float gq[8];
#pragma unroll
    for (int h4 = 0; h4 < 2; ++h4) {
        const f32x4 w0 = *(LAS const f32x4*)(wl + n + 4 * h4), w1 = *(LAS const f32x4*)(wl + FF + n + 4 * h4), w2 = *(LAS const f32x4*)(wl + 2 * FF + n + 4 * h4), cb = *(LAS const f32x4*)(wl + 3 * FF + n + 4 * h4);
#pragma unroll
        for (int q = 0; q < 4; ++q) { const int i = 4 * h4 + q; const float ac = cb[q] + w0[q] * e0[i] + w1[q] * e1[i] + w2[q] * a2[i]; gq[i] = gelu_t(ac) * uu[i]; }
    }
    *(u32x4*)dst = pack8(gq);
}
__device__ __forceinline__ void phase_conv(CParams& P, int l, LAS unsigned char* lds) {
    unsigned char* big = P.ws + WS_BIG;
    bf16_t* Gb = (bf16_t*)(big + B_G); bf16_t* AUS = (bf16_t*)(big + B_AUS);
    const float* HF = (const float*)(big + B_HF); const float* HU = (const float*)(big + B_HU); const float* HL = (const float*)(big + B_HL);
    const int tid = get_tid();
    const int gt = get_bid() * 512 + tid, NGT = get_gdim() * 512;
    LAS float* wl = (LAS float*)lds;
    for (int i = tid; i < 3 * FF; i += 512) wl[i] = P.in[23][(size_t)l * 3 * FF + i];
    for (int i = tid; i < FF; i += 512) wl[3 * FF + i] = P.in[24][(size_t)l * FF + i];
    __syncthreads();
    for (int it = gt; it < 256 * 2 * 352; it += NGT) {
        const int c8 = it % 352, i = (it / 352) & 1, rb = it / 704, n = c8 * 8;
        float a2[8], uu[8], e0[8], e1[8];
        { const float* p = HF + ((size_t)rb * 2 + i) * FF + n; const f32x4 x0 = *(const f32x4*)p, x1 = *(const f32x4*)(p + 4);
          a2[0] = x0[0]; a2[1] = x0[1]; a2[2] = x0[2]; a2[3] = x0[3]; a2[4] = x1[0]; a2[5] = x1[1]; a2[6] = x1[2]; a2[7] = x1[3]; }
        { const float* p = HU + ((size_t)rb * 2 + i) * FF + n; const f32x4 x0 = *(const f32x4*)p, x1 = *(const f32x4*)(p + 4);
          uu[0] = x0[0]; uu[1] = x0[1]; uu[2] = x0[2]; uu[3] = x0[3]; uu[4] = x1[0]; uu[5] = x1[1]; uu[6] = x1[2]; uu[7] = x1[3]; }
        const bool first = (rb & 31) == 0;
        const float* p1 = i == 0 ? (first ? nullptr : HL + ((size_t)(rb - 1) * 2 + 1) * FF + n) : HF + ((size_t)rb * 2) * FF + n;
        const float* p0 = i == 0 ? (first ? nullptr : HL + ((size_t)(rb - 1) * 2 + 0) * FF + n) : (first ? nullptr : HL + ((size_t)(rb - 1) * 2 + 1) * FF + n);
#pragma unroll
        for (int q = 0; q < 8; ++q) { e1[q] = 0.f; e0[q] = 0.f; }
        if (p1) { const f32x4 x0 = *(const f32x4*)p1, x1 = *(const f32x4*)(p1 + 4); e1[0] = x0[0]; e1[1] = x0[1]; e1[2] = x0[2]; e1[3] = x0[3]; e1[4] = x1[0]; e1[5] = x1[1]; e1[6] = x1[2]; e1[7] = x1[3]; }
        if (p0) { const f32x4 x0 = *(const f32x4*)p0, x1 = *(const f32x4*)(p0 + 4); e0[0] = x0[0]; e0[1] = x0[1]; e0[2] = x0[2]; e0[3] = x0[3]; e0[4] = x1[0]; e0[5] = x1[1]; e0[6] = x1[2]; e0[7] = x1[3]; }
        conv_item(e0, e1, a2, uu, wl, n, Gb + ((size_t)rb * 64 + i) * FF + n);
    }
    for (int it = gt; it < 8 * 2 * 704; it += NGT) { const int c4 = (it % 704) * 4, j = (it / 704) & 1, b = it / 1408;
        *(f32x4*)(P.out + O_CONVP + ((size_t)(l * 8 + b) * 2 + j) * FF + c4) = *(const f32x4*)(HL + ((size_t)(b * 32 + 31) * 2 + j) * FF + c4); }
    for (int it = gt; it < 512 * 352; it += NGT) {
        const int srow = it / 352, n = (it % 352) * 8;
        const bf16_t* row = AUS + (size_t)srow * AUW;
        float a2[8], uu[8], e0[8], e1[8];
        unpack8(*(const u32x4*)(row + n), a2); unpack8(*(const u32x4*)(row + FF + n), uu);
        const int bs = srow >> 2, t = srow & 3;
        const float* sb = P.in[6] + ((size_t)(l * 128 + bs) * 2) * FF + n;
        if (t >= 1) unpack8(*(const u32x4*)(row - AUW + n), e1); else { const f32x4 x0 = *(const f32x4*)(sb + FF), x1 = *(const f32x4*)(sb + FF + 4);
            e1[0] = x0[0]; e1[1] = x0[1]; e1[2] = x0[2]; e1[3] = x0[3]; e1[4] = x1[0]; e1[5] = x1[1]; e1[6] = x1[2]; e1[7] = x1[3]; }
        if (t >= 2) unpack8(*(const u32x4*)(row - 2 * AUW + n), e0); else { const float* s2 = sb + (t == 0 ? 0 : FF); const f32x4 x0 = *(const f32x4*)s2, x1 = *(const f32x4*)(s2 + 4);
            e0[0] = x0[0]; e0[1] = x0[1]; e0[2] = x0[2]; e0[3] = x0[3]; e0[4] = x1[0]; e0[5] = x1[1]; e0[6] = x1[2]; e0[7] = x1[3]; }
        if (t >= 2) { float* o = P.out + O_CONVS + ((size_t)(l * 128 + bs) * 2 + (t - 2)) * FF + n;
            *(f32x4*)o = (f32x4){a2[0], a2[1], a2[2], a2[3]}; *(f32x4*)(o + 4) = (f32x4){a2[4], a2[5], a2[6], a2[7]}; }
        conv_item(e0, e1, a2, uu, wl, n, Gb + (size_t)(MP + srow) * FF + n);
    }
}

__device__ __forceinline__ void phase_final(CParams& P) {
    const int tid = get_tid(), wid = tid >> 6, lane = tid & 63;
    const int gw = get_bid() * 8 + wid, NGW = get_gdim() * 8;
    float* X = P.out; const bf16_t* XB = (const bf16_t*)(P.ws + WS_XB); const float* SS = (const float*)(P.ws + WS_SS); const float* gf = P.in[26];
    for (int row = gw; row < MTOK; row += NGW) {
        float s = lane < 16 ? SS[(size_t)lane * MTOK + row] : 0.f; s = wave_sum(s);
        const float rstd = rsqrtf(s * (1.f / 1024.f) + EPS);
#pragma unroll
        for (int j = 0; j < 4; ++j) { float* p = X + (size_t)row * 1024 + 4 * lane + 256 * j; const u32x2 xr = *(const u32x2*)(XB + (size_t)row * 1024 + 4 * lane + 256 * j);
            const f32x4 v = (f32x4){bflo(xr.x), bfhi(xr.x), bflo(xr.y), bfhi(xr.y)}, gg = *(const f32x4*)(gf + 4 * lane + 256 * j);
            *(f32x4*)p = v * rstd * gg; }
    }
}

__device__ __forceinline__ void small_resid_unit(const bf16_t* A, int lda, const bf16_t* Bt, int ldb, int K, int r0, int c0, bf16_t* XB, float* ss, LAS unsigned char* lds) {
    const int tid = get_tid(), wid = tid >> 6, lane = tid & 63, fr = lane & 15, fq = lane >> 4;
    LAS float* red = (LAS float*)lds;
    const int kw = K >> 3, k0 = wid * kw, nsteps = kw >> 5;
    const bf16_t* ap = A + (size_t)(r0 + fr) * lda + k0 + 8 * fq;
    const bf16_t* bp = Bt + (size_t)(c0 + fr) * ldb + k0 + 8 * fq;
    f32x4 acc[2][4];
#pragma unroll
    for (int mi = 0; mi < 2; ++mi)
#pragma unroll
        for (int ni = 0; ni < 4; ++ni) acc[mi][ni] = (f32x4){0.f, 0.f, 0.f, 0.f};
    bf16x8 a[2][2], b[2][4];
#pragma unroll
    for (int i = 0; i < 4; ++i) { if (i < 2) a[0][i] = *(const bf16x8*)(ap + (size_t)(16 * i) * lda); b[0][i] = *(const bf16x8*)(bp + (size_t)(16 * i) * ldb); }
#pragma unroll 1
    for (int st = 0; st < nsteps; st += 2) {
        if (st + 1 < nsteps) {
#pragma unroll
            for (int i = 0; i < 4; ++i) { if (i < 2) a[1][i] = *(const bf16x8*)(ap + (size_t)(16 * i) * lda + 32 * (st + 1)); b[1][i] = *(const bf16x8*)(bp + (size_t)(16 * i) * ldb + 32 * (st + 1)); } }
#pragma unroll
        for (int mi = 0; mi < 2; ++mi)
#pragma unroll
            for (int ni = 0; ni < 4; ++ni) acc[mi][ni] = __builtin_amdgcn_mfma_f32_16x16x32_bf16(a[0][mi], b[0][ni], acc[mi][ni], 0, 0, 0);
        if (st + 1 < nsteps) {
            if (st + 2 < nsteps) {
#pragma unroll
                for (int i = 0; i < 4; ++i) { if (i < 2) a[0][i] = *(const bf16x8*)(ap + (size_t)(16 * i) * lda + 32 * (st + 2)); b[0][i] = *(const bf16x8*)(bp + (size_t)(16 * i) * ldb + 32 * (st + 2)); } }
#pragma unroll
            for (int mi = 0; mi < 2; ++mi)
#pragma unroll
                for (int ni = 0; ni < 4; ++ni) acc[mi][ni] = __builtin_amdgcn_mfma_f32_16x16x32_bf16(a[1][mi], b[1][ni], acc[mi][ni], 0, 0, 0);
        }
    }
#pragma unroll
    for (int mi = 0; mi < 2; ++mi)
#pragma unroll
        for (int ni = 0; ni < 4; ++ni)
#pragma unroll
            for (int j = 0; j < 4; ++j) red[wid * 2048 + (16 * mi + 4 * fq + j) * 64 + 16 * ni + fr] = acc[mi][ni][j];
    __syncthreads();
    const int row = tid >> 4, cb = (tid & 15) * 4;
    const u32x2 xr = *(const u32x2*)(XB + (size_t)(r0 + row) * 1024 + c0 + cb);
    f32x4 v = (f32x4){bflo(xr.x), bfhi(xr.x), bflo(xr.y), bfhi(xr.y)};
#pragma unroll
    for (int w = 0; w < 8; ++w) v += *(LAS const f32x4*)(red + w * 2048 + row * 64 + cb);
    float sq = v[0] * v[0] + v[1] * v[1] + v[2] * v[2] + v[3] * v[3];
    u32x2 o; o.x = cvt_pk_bf16(v[0], v[1]); o.y = cvt_pk_bf16(v[2], v[3]); *(u32x2*)(XB + (size_t)(r0 + row) * 1024 + c0 + cb) = o;
    sq += __shfl_xor(sq, 1); sq += __shfl_xor(sq, 2); sq += __shfl_xor(sq, 4); sq += __shfl_xor(sq, 8);
    if ((tid & 15) == 0) ss[(size_t)(c0 >> 6) * MTOK + r0 + row] = sq;
    __syncthreads();
}

__device__ __forceinline__ void small_oddin_unit(const bf16_t* A, int lda, const bf16_t* Bt, int ldb, int K, int r0, int c0, const float* ss, bf16_t* U, bf16_t* V, float* lns, LAS unsigned char* lds) {
    const int tid = get_tid(), wid = tid >> 6, lane = tid & 63, fr = lane & 15, fq = lane >> 4;
    LAS float* red = (LAS float*)lds;
    const int kw = K >> 3, k0 = wid * kw, nsteps = kw >> 5;
    const bf16_t* ap = A + (size_t)(r0 + fr) * lda + k0 + 8 * fq;
    const bf16_t* bp = Bt + (size_t)(c0 + fr) * ldb + k0 + 8 * fq;
    f32x4 acc[4][4];
#pragma unroll
    for (int mi = 0; mi < 4; ++mi)
#pragma unroll
        for (int ni = 0; ni < 4; ++ni) acc[mi][ni] = (f32x4){0.f, 0.f, 0.f, 0.f};
    bf16x8 a[2][4], b[2][4];
#pragma unroll
    for (int i = 0; i < 4; ++i) { a[0][i] = *(const bf16x8*)(ap + (size_t)(16 * i) * lda); b[0][i] = *(const bf16x8*)(bp + (size_t)(16 * i) * ldb); }
#pragma unroll 1
    for (int st = 0; st < nsteps; st += 2) {
        if (st + 1 < nsteps) {
#pragma unroll
            for (int i = 0; i < 4; ++i) { a[1][i] = *(const bf16x8*)(ap + (size_t)(16 * i) * lda + 32 * (st + 1)); b[1][i] = *(const bf16x8*)(bp + (size_t)(16 * i) * ldb + 32 * (st + 1)); } }
#pragma unroll
        for (int mi = 0; mi < 4; ++mi)
#pragma unroll
            for (int ni = 0; ni < 4; ++ni) acc[mi][ni] = __builtin_amdgcn_mfma_f32_16x16x32_bf16(a[0][mi], b[0][ni], acc[mi][ni], 0, 0, 0);
        if (st + 1 < nsteps) {
            if (st + 2 < nsteps) {
#pragma unroll
                for (int i = 0; i < 4; ++i) { a[0][i] = *(const bf16x8*)(ap + (size_t)(16 * i) * lda + 32 * (st + 2)); b[0][i] = *(const bf16x8*)(bp + (size_t)(16 * i) * ldb + 32 * (st + 2)); } }
#pragma unroll
            for (int mi = 0; mi < 4; ++mi)
#pragma unroll
                for (int ni = 0; ni < 4; ++ni) acc[mi][ni] = __builtin_amdgcn_mfma_f32_16x16x32_bf16(a[1][mi], b[1][ni], acc[mi][ni], 0, 0, 0);
        }
    }
#pragma unroll
    for (int mi = 0; mi < 4; ++mi)
#pragma unroll
        for (int ni = 0; ni < 4; ++ni)
#pragma unroll
            for (int j = 0; j < 4; ++j) red[wid * 4096 + (16 * mi + 4 * fq + j) * 64 + 16 * ni + fr] = acc[mi][ni][j];
    __syncthreads();
    const int row = tid >> 3, cb = (tid & 7) * 8;
    float v[8];
#pragma unroll
    for (int q = 0; q < 8; ++q) v[q] = 0.f;
    float s2 = 0.f;
#pragma unroll
    for (int j = 0; j < 16; ++j) s2 += ss[(size_t)j * MTOK + r0 + row];
    const float rstd = rsqrtf(s2 * (1.f / 1024.f) + EPS);
#pragma unroll
    for (int w = 0; w < 8; ++w) { const f32x4 p0 = *(LAS const f32x4*)(red + w * 4096 + row * 64 + cb), p1 = *(LAS const f32x4*)(red + w * 4096 + row * 64 + cb + 4);
        v[0] += p0[0]; v[1] += p0[1]; v[2] += p0[2]; v[3] += p0[3]; v[4] += p1[0]; v[5] += p1[1]; v[6] += p1[2]; v[7] += p1[3]; }
    float sm = 0.f, sq = 0.f;
#pragma unroll
    for (int q = 0; q < 8; ++q) { v[q] = gelu_t(v[q] * rstd); sm += v[q]; sq += v[q] * v[q]; }
    const bool isv = c0 >= 1024;
    bf16_t* dst = isv ? V + (size_t)(r0 + row) * 1024 + (c0 - 1024) + cb : U + (size_t)(r0 + row) * 1024 + c0 + cb;
    *(u32x4*)dst = pack8(v);
    sm += __shfl_xor(sm, 1); sm += __shfl_xor(sm, 2); sm += __shfl_xor(sm, 4);
    sq += __shfl_xor(sq, 1); sq += __shfl_xor(sq, 2); sq += __shfl_xor(sq, 4);
    if (isv && (tid & 7) == 0) { const int slot = (c0 - 1024) >> 6; lns[(size_t)slot * MTOK + r0 + row] = sm; lns[(size_t)(16 + slot) * MTOK + r0 + row] = sq; }
    __syncthreads();
}

#define XB_TMO      128
#define XB_XCNT(j)  (256  + 64 * (j))
#define XB_XSUB(j)  (1280 + 64 * (j))
#define XB_XGEN(j)  (2304 + 64 * (j))
#define XB_TOP      3328
#define XB_TOPGEN   3392
#define XCD_BAR_WORDS 3456
#define XB_SPIN_CAP (1u << 18)
__device__ __forceinline__ unsigned xb_ld(unsigned* p)              { return __hip_atomic_load(p, __ATOMIC_RELAXED, __HIP_MEMORY_SCOPE_AGENT); }
__device__ __forceinline__ unsigned xb_add(unsigned* p, unsigned v) { return __hip_atomic_fetch_add(p, v, __ATOMIC_RELAXED, __HIP_MEMORY_SCOPE_AGENT); }
__device__ __forceinline__ unsigned xb_xcc_id() { return (unsigned)__builtin_amdgcn_s_getreg((3 << 11) | 20) & 0xFu; }
#define XB_SPIN(cond, bar) do { unsigned _sp = 0; while (cond) { __builtin_amdgcn_s_sleep(1); \
    if ((++_sp & 255u) == 0u) { if (xb_ld(&(bar)[XB_TMO])) break; if (_sp > XB_SPIN_CAP) { atomicAdd(&(bar)[XB_TMO], 1u); break; } } } } while (0)
struct XcdBarrier { unsigned* bar; unsigned x; volatile LAS unsigned* st; };
__device__ __forceinline__ XcdBarrier xcd_barrier_post(unsigned* bar, volatile LAS unsigned* st) {
    XcdBarrier b; b.bar = bar; b.x = xb_xcc_id(); b.st = st;
    if (threadIdx.x == 0) (void)xb_add(&bar[XB_XCNT(b.x)], 1u);
    return b;
}
__device__ __forceinline__ void xcd_barrier_complete(unsigned* bar, unsigned x, unsigned& nloc, unsigned& nx) {
    const unsigned G = gridDim.x * gridDim.y * gridDim.z;
    unsigned sum, cnt, mine, sp = 0u;
    for (;;) {
        sum = 0u; cnt = 0u; mine = 0u;
#pragma unroll
        for (unsigned j = 0; j < 16; ++j) { const unsigned c = xb_ld(&bar[XB_XCNT(j)]); sum += c; cnt += (c > 0u) ? 1u : 0u; mine = (j == x) ? c : mine; }
        if (sum == G) break;
        __builtin_amdgcn_s_sleep(1);
        if ((++sp & 255u) == 0u) { if (xb_ld(&bar[XB_TMO])) break; if (sp > XB_SPIN_CAP) { atomicAdd(&bar[XB_TMO], 1u); break; } }
    }
    nloc = mine > 0u ? mine : 1u; nx = cnt > 0u ? cnt : 1u;
}
__device__ __forceinline__ void xcd_barrier(const XcdBarrier& b) {
    asm volatile("s_waitcnt vmcnt(0)" ::: "memory");
    __syncthreads();
    if (threadIdx.x == 0) {
        unsigned* bar = b.bar;
        __builtin_amdgcn_s_waitcnt(0);
        unsigned nloc = b.st[0], nx = b.st[1];
        if (nloc == 0u) { xcd_barrier_complete(bar, b.x, nloc, nx); b.st[0] = nloc; b.st[1] = nx; }
        const unsigned old = xb_add(&bar[XB_XSUB(b.x)], 1u);
        const unsigned gen = old / nloc;
        if (old + 1u == (gen + 1u) * nloc) {
            __builtin_amdgcn_fence(__ATOMIC_RELEASE, "agent");
            asm volatile("s_waitcnt vmcnt(0)" ::: "memory");
            const unsigned og = xb_add(&bar[XB_TOP], 1u);
            const unsigned tg = og / nx;
            if (og + 1u == (tg + 1u) * nx) xb_add(&bar[XB_TOPGEN], 1u);
            else XB_SPIN(xb_ld(&bar[XB_TOPGEN]) == tg, bar);
            __builtin_amdgcn_fence(__ATOMIC_ACQUIRE, "agent");
            xb_add(&bar[XB_XGEN(b.x)], 1u);
            asm volatile("s_waitcnt vmcnt(0)" ::: "memory");
        } else {
            XB_SPIN(xb_ld(&bar[XB_XGEN(b.x)]) == gen, bar);
            __builtin_amdgcn_fence(__ATOMIC_ACQUIRE, "agent");
            asm volatile("s_waitcnt vmcnt(0)" ::: "memory");
        }
    }
    __syncthreads();
}

__global__ void __launch_bounds__(512) mega(const Params Pkarg, const int ph_lo, const int ph_hi) {
    extern __shared__ __attribute__((aligned(16))) unsigned char shm[];
    LAS unsigned char* lds = (LAS unsigned char*)shm;
    LAS float* rsbuf = (LAS float*)(lds + pg8::STAGE_BYTES);
    volatile LAS unsigned* xbst = (volatile LAS unsigned*)(lds + LDS_BYTES - 16);
    XcdBarrier xb; xb.bar = nullptr; xb.x = 0; xb.st = xbst;
    if (ph_hi - ph_lo > 1) {
        if (threadIdx.x == 0) { xbst[0] = 0u; xbst[1] = 0u; }
        __syncthreads();
        xb = xcd_barrier_post((unsigned*)(((CParams*)__builtin_amdgcn_kernarg_segment_ptr())->ws + WS_BAR), xbst);
    }
    for (int ph = ph_lo; ph < ph_hi; ++ph) {
        const int G = get_gdim(), bid = get_bid();
        CParams* Pp = (CParams*)__builtin_amdgcn_kernarg_segment_ptr();
        asm volatile("" : "+s"(Pp));
        CParams& P = *Pp;
        unsigned char* big = P.ws + WS_BIG;
        int kind, l = 0;
        if (ph == 0) kind = 0;
        else if (ph == NPHASE - 1) kind = 12;
        else { int q = ph - 1; if (q < 8) l = 0; else if (q < 14) { l = 1; q -= 8; } else if (q < 22) { l = 2; q -= 14; } else { l = 3; q -= 22; }
            const int nm = (l & 1) ? 3 : 5; kind = q < nm ? ((l & 1) ? 6 + q : 1 + q) : 9 + (q - nm); }
        const int e = l >> 1;
#ifdef DUP_KIND
        const int reps = (kind == DUP_KIND) ? 3 : 1;
#else
        const int reps = 1;
#endif
        for (int rep = 0; rep < reps; ++rep)
        switch (kind) {
#ifndef PMASK
#define PMASK 0xFFFF
#endif
#define PM(k) if (PMASK & (1 << (k)))
        case 0: PM(0) phase_prep(P, lds); break;
        case 1: PM(1) {
            pg8::Gemm g{(const bf16_t*)(P.ws + WS_XB), (const bf16_t*)(P.ws + WS_EIN) + (size_t)e * 2560 * 1024, MTOK, 2560, 1024, 1024, 1024};
            pg8::StaticOrder S; S.init(MTOK, 2560, G, bid); pg8::precompute_rstd(S, (const float*)(P.ws + WS_SS), rsbuf);
            pg8::EpiScaleBf16 E{(bf16_t*)(big + B_ZB), NZ, rsbuf};
            pg8::gemm_phase(lds, g, S, E);
            phase_gates(P, e, lds);
        } break;
        case 2: PM(2) {
            for (int j = 0; j * G < 512; ++j) { const int u = (j & 1) ? (j + 1) * G - 1 - bid : j * G + bid; if (u < 512) e2_unit(P, u, lds); }
            for (int u = bid; u < 528; u += G) pool_unit(P, e, u >> 2, u & 3, lds);
        } break;
        case 3: PM(3) {
            phase_scan(P, e, lds);
            for (int u = bid; u < 512; u += G) mlstm_sample_unit(P, e, u, lds);
        } break;
        case 4: PM(4) for (int u = bid; u < 512; u += G) e4_unit(P, e, u, lds); break;
        case 5: case 8: case 11: PM(5) {
            pg8::Gemm g;
            if (kind == 5) g = pg8::Gemm{(const bf16_t*)(big + B_YMIX), (const bf16_t*)(P.ws + WS_EOUT) + (size_t)e * 1024 * 1024, MTOK, 1024, 1024, 1024, 1024};
            else if (kind == 8) g = pg8::Gemm{(const bf16_t*)(big + B_US), (const bf16_t*)(P.ws + WS_OOUT) + (size_t)e * 1024 * 1024, MTOK, 1024, 1024, 1024, 1024};
            else g = pg8::Gemm{(const bf16_t*)(big + B_G), (const bf16_t*)(P.ws + WS_F2) + (size_t)l * 1024 * 2816, MTOK, 1024, FF, FF, FF};
            pg8::StaticOrder S; S.init(MP, 1024, G, bid);
            pg8::EpiResid E{(bf16_t*)(P.ws + WS_XB), (float*)(P.ws + WS_SS)};
            pg8::gemm_phase(lds, g, S, E);
            for (int u = bid; u < 256; u += G)
                small_resid_unit(g.A, g.lda, g.Bt, g.ldb, g.K, MP + (u >> 4) * 32, (u & 15) * 64, (bf16_t*)(P.ws + WS_XB), (float*)(P.ws + WS_SS), lds);
        } break;
        case 6: PM(6) {
            pg8::Gemm g{(const bf16_t*)(P.ws + WS_XB), (const bf16_t*)(P.ws + WS_OIN) + (size_t)e * 2048 * 1024, MTOK, 2048, 1024, 1024, 1024};
            pg8::StaticOrder S; S.init(MP, 2048, G, bid); pg8::precompute_rstd(S, (const float*)(P.ws + WS_SS), rsbuf);
            pg8::EpiOddIn E{(bf16_t*)(big + B_U), (bf16_t*)(big + B_VPRE), (float*)(big + B_LNS), rsbuf};
            pg8::gemm_phase(lds, g, S, E);
            for (int u = bid; u < 256; u += G)
                small_oddin_unit(g.A, g.lda, g.Bt, g.ldb, g.K, MP + (u >> 5) * 64, (u & 31) * 64, (const float*)(P.ws + WS_SS), (bf16_t*)(big + B_U), (bf16_t*)(big + B_VPRE), (float*)(big + B_LNS), lds);
        } break;
        case 7: PM(7) {
            for (int u = bid; u < 512; u += G) sgu_unit(P, e, u, lds);
            sgu_sample(P, e);
        } break;
        case 9: PM(9) {
            pg8::Gemm g{(const bf16_t*)(P.ws + WS_XB), (const bf16_t*)(P.ws + WS_F1) + (size_t)l * 5632 * 1024, MTOK, 5632, 1024, 1024, 1024};
            pg8::StaticOrder S; S.init(MTOK, 5632, G, bid); pg8::precompute_rstd(S, (const float*)(P.ws + WS_SS), rsbuf);
            pg8::EpiFfn E{(bf16_t*)(big + B_G), (bf16_t*)(big + B_AUS), (float*)(big + B_HF), (float*)(big + B_HU), (float*)(big + B_HL), rsbuf, P.in[23] + (size_t)l * 3 * FF, P.in[24] + (size_t)l * FF};
            pg8::gemm_phase(lds, g, S, E);
        } break;
        case 10: PM(10) phase_conv(P, l, lds); break;
        case 12: PM(12) phase_final(P); break;
        }
#if USE_CG_SYNC
        if (ph + 1 < ph_hi) cg::this_grid().sync();
#else
        if (ph + 1 < ph_hi) { if (ph_lo < 0) cg::this_grid().sync(); else xcd_barrier(xb); }
#endif
    }
}

static void add_job(Params& p, int& nj, int& items, const float* W, bf16_t* WT, const float* gk, int K, int ldw, int ncols, int ldt, int n_lo, int n_hi, float nscale) {
    TJob& j = p.jobs[nj++]; j.W = W; j.WT = WT; j.gk = gk; j.K = K; j.ldw = ldw; j.ncols = ncols; j.ldt = ldt; j.n_lo = n_lo; j.n_hi = n_hi; j.nscale = nscale; j.item0 = items; j.rmode = 0; j.roff = 0;
    items += (K / 64) * (ncols / 32);
}

extern "C" void kernel_launch(void* const* d_in, const int* in_sizes, int n_in, void* d_out, int out_size, void* d_ws, size_t ws_size, hipStream_t stream) {
    static int grid = 0;
    if (grid == 0) {
        if (n_in != 27 || ws_size < WS_END) { fprintf(stderr, "kernel_launch: need 27 inputs and %zu bytes of workspace (got %d, %zu)\n", (size_t)WS_END, n_in, ws_size); grid = -1; return; }
        int dev = 0, cus = 0, per_cu = 0;
        (void)hipGetDevice(&dev); (void)hipDeviceGetAttribute(&cus, hipDeviceAttributeMultiprocessorCount, dev);
        if (hipFuncSetAttribute((const void*)mega, hipFuncAttributeMaxDynamicSharedMemorySize, LDS_BYTES) != hipSuccess) { fprintf(stderr, "hipFuncSetAttribute failed\n"); grid = -1; return; }
        (void)hipOccupancyMaxActiveBlocksPerMultiprocessor(&per_cu, (const void*)mega, 512, LDS_BYTES);
        if (per_cu < 1) per_cu = 1;
        (void)hipGetLastError();
        grid = cus * 1;
    }
    if (grid < 0) return;
    Params p; memset(&p, 0, sizeof(p));
    for (int i = 0; i < 27; ++i) p.in[i] = (const float*)d_in[i];
    p.out = (float*)d_out; p.ws = (unsigned char*)d_ws;
    unsigned char* ws = (unsigned char*)d_ws;
    int nj = 0, items = 0;
    const float kq = 0.08838834764831845f;
    for (int e = 0; e < 2; ++e) add_job(p, nj, items, p.in[8] + (size_t)e * 1024 * 2568, (bf16_t*)(ws + WS_EIN) + (size_t)e * 2560 * 1024, p.in[7] + (2 * e) * 1024, 1024, 2568, 2560, 1024, 1024, 1536, kq);
    for (int e = 0; e < 2; ++e) add_job(p, nj, items, p.in[13] + (size_t)e * 1024 * 1024, (bf16_t*)(ws + WS_EOUT) + (size_t)e * 1024 * 1024, nullptr, 1024, 1024, 1024, 1024, 0, 0, 1.f);
    for (int o = 0; o < 2; ++o) add_job(p, nj, items, p.in[14] + (size_t)o * 1024 * 2048, (bf16_t*)(ws + WS_OIN) + (size_t)o * 2048 * 1024, p.in[7] + (2 * o + 1) * 1024, 1024, 2048, 2048, 1024, 0, 0, 1.f);
    for (int o = 0; o < 2; ++o) add_job(p, nj, items, p.in[19] + (size_t)o * 1024 * 1024, (bf16_t*)(ws + WS_OOUT) + (size_t)o * 1024 * 1024, nullptr, 1024, 1024, 1024, 1024, 0, 0, 1.f);
    for (int l = 0; l < 4; ++l) {
        add_job(p, nj, items, p.in[21] + (size_t)l * 1024 * FF, (bf16_t*)(ws + WS_F1) + (size_t)l * 5632 * 1024, p.in[20] + l * 1024, 1024, FF, FF, 1024, 0, 0, 1.f);
        p.jobs[nj - 1].rmode = 1; p.jobs[nj - 1].roff = 0;
        add_job(p, nj, items, p.in[22] + (size_t)l * 1024 * FF, (bf16_t*)(ws + WS_F1) + (size_t)l * 5632 * 1024, p.in[20] + l * 1024, 1024, FF, FF, 1024, 0, 0, 1.f);
        p.jobs[nj - 1].rmode = 1; p.jobs[nj - 1].roff = 128;
    }
    for (int l = 0; l < 4; ++l) add_job(p, nj, items, p.in[25] + (size_t)l * FF * 1024, (bf16_t*)(ws + WS_F2) + (size_t)l * 1024 * FF, nullptr, FF, 1024, 1024, FF, 0, 0, 1.f);
    p.nitems = items;
#ifndef RUN_HI
#define RUN_HI NPHASE
#endif
#if ONE_LAUNCH
    (void)hipMemsetAsync((unsigned char*)d_ws + WS_BAR, 0, 16384, stream);
    int lo = 0, hi = RUN_HI;
    void* args[] = {(void*)&p, (void*)&lo, (void*)&hi};
    hipError_t err = hipLaunchCooperativeKernel((const void*)mega, dim3(grid), dim3(512), args, LDS_BYTES, stream);
    if (err != hipSuccess) fprintf(stderr, "cooperative launch failed: %s (grid %d)\n", hipGetErrorString(err), grid);
#else
    for (int ph = 0; ph < RUN_HI; ++ph) hipLaunchKernelGGL(mega, dim3(grid), dim3(512), LDS_BYTES, stream, p, ph, ph + 1);
#endif
}
```
